# Optimizing an MI355X kernel written in HIP

```python
import jax, jax.numpy as jnp
from jax import lax
import numpy as np

D_MODEL = 1024
BATCH = 4
SEQ = 4096
DEPTH = 1

N_SB_HEADS = 8
SB_HEAD_DIM = 64
SB_WIDTH = N_SB_HEADS * SB_HEAD_DIM
POOL_WINDOWS = (2, 4, 8, 16)
N_POOL_GROUPS = len(POOL_WINDOWS)
POOL_GROUP_DIM = 128
POOL_WIDTH = N_POOL_GROUPS * POOL_GROUP_DIM
MIX_WIDTH = SB_WIDTH + POOL_WIDTH
IN_PROJ_WIDTH = 3 * SB_WIDTH + POOL_WIDTH
Q_BLOCK = 128
N_EXPERT_GROUPS = 4
EXPERTS_PER_GROUP = 4
N_EXPERTS = N_EXPERT_GROUPS * EXPERTS_PER_GROUP
TOP_K_IN_GROUP = 2
EXPERT_HIDDEN = 512
DEEPNORM_ALPHA = (2.0 * DEPTH) ** 0.25
DEEPNORM_BETA = (8.0 * DEPTH) ** -0.25
LN_EPS = 1e-5
N_MOD = 6

kernel_name = "hybrid_stickbreak_pool_hmoe_deepnorm_adaln"


def layer_norm(x, gain=None, bias=None):
    xf = x.astype(jnp.float32)
    mu = jnp.mean(xf, axis=-1, keepdims=True)
    var = jnp.mean(jnp.square(xf - mu), axis=-1, keepdims=True)
    y = (xf - mu) * lax.rsqrt(var + LN_EPS)
    if gain is not None:
        y = y * gain.astype(jnp.float32) + bias.astype(jnp.float32)
    return y.astype(x.dtype)


def stick_breaking_attention(q, k, v):
    seq = q.shape[2]
    scale = SB_HEAD_DIM ** -0.5
    outs = []
    for blk in range(seq // Q_BLOCK):
        start = blk * Q_BLOCK
        end = start + Q_BLOCK
        qb = q[:, :, start:end]
        kb = k[:, :, :end]
        vb = v[:, :, :end]
        z = jnp.einsum('bhqd,bhkd->bhqk', qb, kb).astype(jnp.float32) * scale
        q_pos = start + jnp.arange(Q_BLOCK)[:, None]
        k_pos = jnp.arange(end)[None, :]
        causal = k_pos < q_pos
        log_beta = jnp.where(causal, jax.nn.log_sigmoid(z), -jnp.inf)
        log_not_beta = jnp.where(causal, jax.nn.log_sigmoid(-z), 0.0)
        after = lax.cumsum(log_not_beta, axis=3, reverse=True) - log_not_beta
        att = jnp.exp(log_beta + after)
        outs.append(jnp.einsum('bhqk,bhkd->bhqd', att.astype(vb.dtype), vb))
    return jnp.concatenate(outs, axis=2)


def causal_pool_minus_self(xg, window):
    seq = xg.shape[1]
    xf = xg.astype(jnp.float32)
    cs = jnp.cumsum(xf, axis=1)
    lag = jnp.pad(cs, ((0, 0), (window, 0), (0, 0)))[:, :seq]
    count = jnp.minimum(jnp.arange(seq) + 1, window).astype(jnp.float32)
    mean = (cs - lag) / count[None, :, None]
    return (mean - xf).astype(xg.dtype)


def multiscale_pool(p, w_pool, pool_scale):
    b, s, _ = p.shape
    groups = [causal_pool_minus_self(p[..., g * POOL_GROUP_DIM:(g + 1) * POOL_GROUP_DIM], w)
              for g, w in enumerate(POOL_WINDOWS)]
    pooled = jnp.stack(groups, axis=2)
    mixed = jnp.einsum('bsgc,gce->bsge', pooled, w_pool).reshape(b, s, POOL_WIDTH)
    return mixed * pool_scale


def hierarchical_moe(u, w_rg, b_rg, w_re, b_re, w_gate, w_up, w_down):
    t, d = u.shape
    g_logits = (u @ w_rg).astype(jnp.float32) + b_rg.astype(jnp.float32)
    g_prob = jax.nn.softmax(g_logits, axis=-1)
    g_p, g_idx = lax.top_k(g_prob, 1)
    e_logits = ((u @ w_re).astype(jnp.float32) + b_re.astype(jnp.float32)).reshape(
        t, N_EXPERT_GROUPS, EXPERTS_PER_GROUP)
    e_sel = jnp.take_along_axis(e_logits, g_idx[:, :, None], axis=1)[:, 0]
    e_top, e_idx = lax.top_k(e_sel, TOP_K_IN_GROUP)
    e_w = jax.nn.softmax(e_top, axis=-1) * g_p
    expert_id = g_idx * EXPERTS_PER_GROUP + e_idx
    combine = jnp.sum(jax.nn.one_hot(expert_id, N_EXPERTS, dtype=jnp.float32) * e_w[..., None],
                      axis=1)
    y = jnp.zeros((t, d), jnp.float32)
    for e in range(N_EXPERTS):
        h = jax.nn.silu(u @ w_gate[e]) * (u @ w_up[e])
        y = y + combine[:, e:e + 1] * (h @ w_down[e]).astype(jnp.float32)
    return y.astype(u.dtype)


def setup_inputs(seed: int = 0) -> dict:
    key = jax.random.key(seed)
    ks = jax.random.split(key, 20)
    f32 = jnp.float32
    n = lambda k, shape, s: jax.random.normal(k, shape, f32) * s
    d = D_MODEL
    w_in = n(ks[4], (DEPTH, d, IN_PROJ_WIDTH), d ** -0.5)
    v_cols = jnp.zeros((IN_PROJ_WIDTH,), f32).at[2 * SB_WIDTH:3 * SB_WIDTH].set(1.0)
    w_in = w_in * (1.0 + (DEEPNORM_BETA - 1.0) * v_cols)
    return {
        "x": n(ks[0], (BATCH, SEQ, d), 1.0),
        "c": n(ks[1], (BATCH, d), 1.0),
        "w_ada": n(ks[2], (DEPTH, d, N_MOD * d), 0.1 * d ** -0.5),
        "b_ada": n(ks[3], (DEPTH, N_MOD * d), 0.01),
        "w_in": w_in,
        "w_pool": n(ks[5], (DEPTH, N_POOL_GROUPS, POOL_GROUP_DIM, POOL_GROUP_DIM), POOL_GROUP_DIM ** -0.5),
        "pool_scale": 1.0 + n(ks[6], (DEPTH, POOL_WIDTH), 0.05),
        "w_out": n(ks[7], (DEPTH, MIX_WIDTH, d), DEEPNORM_BETA * MIX_WIDTH ** -0.5),
        "ln1_g": 1.0 + n(ks[8], (DEPTH, d), 0.02),
        "ln1_b": n(ks[9], (DEPTH, d), 0.02),
        "w_router_group": n(ks[10], (DEPTH, d, N_EXPERT_GROUPS), d ** -0.5),
        "b_router_group": n(ks[11], (DEPTH, N_EXPERT_GROUPS), 0.01),
        "w_router_expert": n(ks[12], (DEPTH, d, N_EXPERTS), d ** -0.5),
        "b_router_expert": n(ks[13], (DEPTH, N_EXPERTS), 0.01),
        "w_gate": n(ks[14], (DEPTH, N_EXPERTS, d, EXPERT_HIDDEN), d ** -0.5),
        "w_up": n(ks[15], (DEPTH, N_EXPERTS, d, EXPERT_HIDDEN), DEEPNORM_BETA * d ** -0.5),
        "w_down": n(ks[16], (DEPTH, N_EXPERTS, EXPERT_HIDDEN, d), DEEPNORM_BETA * EXPERT_HIDDEN ** -0.5),
        "ln2_g": 1.0 + n(ks[17], (DEPTH, d), 0.02),
        "ln2_b": n(ks[18], (DEPTH, d), 0.02),
    }


def reference(x, c, w_ada, b_ada, w_in, w_pool, pool_scale, w_out, ln1_g, ln1_b,
              w_router_group, b_router_group, w_router_expert, b_router_expert,
              w_gate, w_up, w_down, ln2_g, ln2_b):
    b, s, d = x.shape
    heads = lambda t: t.reshape(b, s, N_SB_HEADS, SB_HEAD_DIM).transpose(0, 2, 1, 3)
    for layer in range(DEPTH):
        mod = jax.nn.silu(c) @ w_ada[layer] + b_ada[layer]
        shift1, scale1, gate1, shift2, scale2, gate2 = [m[:, None, :] for m in jnp.split(mod, N_MOD, axis=-1)]

        u = layer_norm(x) * (1.0 + scale1) + shift1
        proj = u @ w_in[layer]
        q, k, v, p = jnp.split(proj, [SB_WIDTH, 2 * SB_WIDTH, 3 * SB_WIDTH], axis=-1)
        o_sb = stick_breaking_attention(heads(q), heads(k), heads(v))
        o_sb = o_sb.transpose(0, 2, 1, 3).reshape(b, s, SB_WIDTH)
        o_pool = multiscale_pool(p, w_pool[layer], pool_scale[layer])
        mixed = jnp.concatenate([o_sb, o_pool], axis=-1) @ w_out[layer]
        x = layer_norm(DEEPNORM_ALPHA * x + (1.0 + gate1) * mixed, ln1_g[layer], ln1_b[layer])

        u = layer_norm(x) * (1.0 + scale2) + shift2
        y = hierarchical_moe(u.reshape(b * s, d), w_router_group[layer], b_router_group[layer],
                             w_router_expert[layer], b_router_expert[layer],
                             w_gate[layer], w_up[layer], w_down[layer]).reshape(b, s, d)
        x = layer_norm(DEEPNORM_ALPHA * x + (1.0 + gate2) * y, ln2_g[layer], ln2_b[layer])
    return x
```

```cpp
#include <hip/hip_runtime.h>
#include <cstdio>
#include <cstdint>
#include <cmath>
namespace pg8 {
#define PG8_LAS __attribute__((address_space(3)))
typedef unsigned short bf16_t;
typedef short bf16x8 __attribute__((ext_vector_type(8)));
typedef float f32x4 __attribute__((ext_vector_type(4)));
typedef unsigned u32x4 __attribute__((ext_vector_type(4)));
constexpr int BM = 256, BK = 64, HALF = 128, HTB = HALF * BK * 2  , STAGE_BYTES = 8 * HTB, NXCD = 8, WGM = 8;

__host__ __device__ __forceinline__ int lds_byte(int r, int c) { const int st = (r >> 4) * 2 + (c >> 5), rr = r & 15, cc = c & 31, ob = rr * 64 + cc * 2; return st * 1024 + (ob ^ (((ob >> 9) & 1) << 5)); }
__host__ __device__ __forceinline__ void stage_rc(int b, int& R, int& C) { const int st = b / 1024, sb = b % 1024, swz = sb ^ (((sb >> 9) & 1) << 5); R = (st >> 1) * 16 + swz / 64; C = (st & 1) * 32 + (swz % 64) / 2; }
__host__ __device__ __forceinline__ int perm32(int rho) { const int n = rho >> 4, i = rho & 15; return 8 * (i >> 2) + 4 * n + (i & 3); }

struct Unit { int pm, pn; };
struct Gemm { const bf16_t* A; const bf16_t* Bt; int M, N, K; };

struct StaticOrder {
    int nM, nN, nwg, G, c;
    __host__ __device__ void init(int M, int N, int G_, int c_) { nM = M / BM; nN = N / BM; nwg = nM * nN; G = G_; c = c_; }
    __host__ __device__ bool next(int i, Unit& u) const {
        const long L = (long)i * G + c; if (L >= nwg) return false;
        int wgid = (int)L; { const int q = nwg / NXCD, r = nwg % NXCD, xcd = wgid % NXCD, off = wgid / NXCD; wgid = (xcd < r ? xcd * (q + 1) : r * (q + 1) + (xcd - r) * q) + off; }
        const int nig = WGM * nN, gid = wgid / nig, fm = gid * WGM, gsz = (nM - fm) < WGM ? (nM - fm) : WGM;
        u.pm = fm + ((wgid % nig) % gsz); u.pn = (wgid % nig) / gsz; return true;
    }
    __device__ __forceinline__ void a_ready(const Unit&) const {}
    __device__ __forceinline__ void done(const Unit&) const {}
};


__device__ __forceinline__ unsigned cvt_pk_bf16(float lo, float hi) { unsigned r; asm volatile("v_cvt_pk_bf16_f32 %0, %1, %2" : "=v"(r) : "v"(lo), "v"(hi)); return r; }

struct EpiQKVP {
    static constexpr bool PERM = true, AFTER_DRAIN = false;
    bf16_t* O; size_t split_stride; float scale0;
    __device__ __forceinline__ void operator()(const f32x4 (&acc)[2][2][4][2], const Unit& u, int wr, int wc, int fr, int fq) const {
        const int row0 = u.pm * BM + wr * 64 + fr; const int t = u.pn >> 1; const int colt = (u.pn & 1) * BM;
        bf16_t* base = O + (size_t)t * split_stride; const float sc = (t == 0) ? scale0 : 1.f;
        const int col0 = colt + wc * 32 + 8 * fq;
#pragma unroll
        for (int ai = 0; ai < 2; ++ai)
#pragma unroll
            for (int m = 0; m < 4; ++m) { bf16_t* rowp = base + (size_t)(row0 + ai * HALF + m * 16) * 512 + col0;
#pragma unroll
                for (int bj = 0; bj < 2; ++bj) { const f32x4 v0 = acc[ai][bj][m][0] * sc, v1 = acc[ai][bj][m][1] * sc;
                    u32x4 w; w.x = cvt_pk_bf16(v0[0], v0[1]); w.y = cvt_pk_bf16(v0[2], v0[3]); w.z = cvt_pk_bf16(v1[0], v1[1]); w.w = cvt_pk_bf16(v1[2], v1[3]);
                    *(u32x4*)(rowp + bj * HALF) = w; } }
    }
};
struct EpiY1 {
    static constexpr bool PERM = false, AFTER_DRAIN = false;
    const float* x; float* out; const float* gate; float alpha;
    __device__ __forceinline__ void operator()(const f32x4 (&acc)[2][2][4][2], const Unit& u, int wr, int wc, int fr, int fq) const {
        const int row0 = u.pm * BM + wr * 64 + fr, col0 = u.pn * BM + wc * 32 + 4 * fq;
        const int b = (u.pm * BM) >> 12;
        f32x4 gv[2][2];
#pragma unroll
        for (int bj = 0; bj < 2; ++bj)
#pragma unroll
            for (int n = 0; n < 2; ++n) gv[bj][n] = *(const f32x4*)(gate + b * 6144 + col0 + bj * HALF + n * 16) + 1.0f;
#pragma unroll
        for (int ai = 0; ai < 2; ++ai)
#pragma unroll
            for (int m = 0; m < 4; ++m) { const size_t off = (size_t)(row0 + ai * HALF + m * 16) * 1024 + col0;
#pragma unroll
                for (int bj = 0; bj < 2; ++bj)
#pragma unroll
                    for (int n = 0; n < 2; ++n) { const f32x4 xv = *(const f32x4*)(x + off + bj * HALF + n * 16);
                        *(f32x4*)(out + off + bj * HALF + n * 16) = xv * alpha + gv[bj][n] * acc[ai][bj][m][n]; } }
    }
};
__device__ __forceinline__ float silu_f(float g) { return g * __builtin_amdgcn_rcpf(1.0f + __builtin_amdgcn_exp2f(g * -1.4426950408889634f)); }
struct EpiGateUp {
    static constexpr bool PERM = true, AFTER_DRAIN = false;
    bf16_t* H;
    __device__ __forceinline__ void operator()(const f32x4 (&acc)[2][2][4][2], const Unit& u, int wr, int wc, int fr, int fq) const {
        const int row0 = u.pm * BM + wr * 64 + fr, col0 = (u.pn & 3) * 128 + wc * 32 + 8 * fq;
#pragma unroll
        for (int ai = 0; ai < 2; ++ai)
#pragma unroll
            for (int m = 0; m < 4; ++m) { bf16_t* rowp = H + (size_t)(row0 + ai * HALF + m * 16) * 512 + col0;
                const f32x4 g0 = acc[ai][0][m][0], g1 = acc[ai][0][m][1], u0 = acc[ai][1][m][0], u1 = acc[ai][1][m][1];
                u32x4 w;
                w.x = cvt_pk_bf16(silu_f(g0[0]) * u0[0], silu_f(g0[1]) * u0[1]); w.y = cvt_pk_bf16(silu_f(g0[2]) * u0[2], silu_f(g0[3]) * u0[3]);
                w.z = cvt_pk_bf16(silu_f(g1[0]) * u1[0], silu_f(g1[1]) * u1[1]); w.w = cvt_pk_bf16(silu_f(g1[2]) * u1[2], silu_f(g1[3]) * u1[3]);
                *(u32x4*)rowp = w; }
    }
};
struct EpiDown {
    static constexpr bool PERM = true, AFTER_DRAIN = false;
    bf16_t* Y;
    __device__ __forceinline__ void operator()(const f32x4 (&acc)[2][2][4][2], const Unit& u, int wr, int wc, int fr, int fq) const {
        const int row0 = u.pm * BM + wr * 64 + fr, col0 = (u.pn & 3) * BM + wc * 32 + 8 * fq;
#pragma unroll
        for (int ai = 0; ai < 2; ++ai)
#pragma unroll
            for (int m = 0; m < 4; ++m) { bf16_t* rowp = Y + (size_t)(row0 + ai * HALF + m * 16) * 1024 + col0;
#pragma unroll
                for (int bj = 0; bj < 2; ++bj) { const f32x4 v0 = acc[ai][bj][m][0], v1 = acc[ai][bj][m][1];
                    u32x4 w; w.x = cvt_pk_bf16(v0[0], v0[1]); w.y = cvt_pk_bf16(v0[2], v0[3]); w.z = cvt_pk_bf16(v1[0], v1[1]); w.w = cvt_pk_bf16(v1[2], v1[3]);
                    *(u32x4*)(rowp + bj * HALF) = w; } }
    }
};
struct MoeOrder {
    int tend, total, G, c, lane;
    __device__ __forceinline__ bool next(int i, Unit& u) const {
        const int L = i * G + c, mt = L >> 2; if (mt >= total) return false;
        const unsigned long long bal = __ballot(lane < 16 && mt >= tend);
        u.pm = mt; u.pn = (int)__popcll(bal) * 4 + (L & 3); return true;
    }
    __device__ __forceinline__ void a_ready(const Unit&) const {}
    __device__ __forceinline__ void done(const Unit&) const {}
};

template <class Epi, class Sched, bool ALIGN_EPI = false, bool SP2 = false>
__device__ __forceinline__ void gemm_phase(PG8_LAS unsigned char* lds, const Gemm g, const Sched& S, const Epi& E) {
    const int tid = threadIdx.x, wid = __builtin_amdgcn_readfirstlane(tid >> 6), lane = tid & 63, wr = wid >> 2, wc = wid & 3, fr = lane & 15, fq = lane >> 4;
    const int K = g.K, nt = K / BK;
    unsigned voffA[2], voffB[2];
#pragma unroll
    for (int i = 0; i < 2; ++i) { int R, C; stage_rc(tid * 16 + i * 8192, R, C); const int Rb = Epi::PERM ? ((R & ~31) + perm32(R & 31)) : R;
        voffA[i] = (unsigned)(R * K + C) * 2u; voffB[i] = (unsigned)(Rb * K + C) * 2u; }
    const size_t kstep = (size_t)(BK * 2);
    const size_t hstep = (size_t)HALF * K * 2;
    const size_t tstep = 2 * hstep;
    const unsigned ldsw = (unsigned)wid * 1024u;
    const int aoff = lds_byte(wr * 64 + fr, fq * 8), boff = lds_byte(wc * 32 + fr, fq * 8);
#define PG8_SA(b, h) (((b) * 2 + (h)) * HTB)
#define PG8_SB(b, h) ((4 + (b) * 2 + (h)) * HTB)
#define PG8_STAGE(bufoff, gbase, voff) do { _Pragma("unroll") for (int _i = 0; _i < 2; ++_i) \
        __builtin_amdgcn_global_load_lds((const unsigned*)((const char*)(gbase) + (voff)[_i]), (PG8_LAS unsigned*)(lds + (bufoff) + ldsw + _i * 8192), 16, 0, 0); } while (0)
#define PG8_LDA(dst, b, h) do { _Pragma("unroll") for (int m = 0; m < 4; ++m) _Pragma("unroll") for (int k = 0; k < 2; ++k) dst[m][k] = *(const PG8_LAS bf16x8*)(lds + PG8_SA(b, h) + aoff + m * 2048 + k * 1024); } while (0)
#define PG8_LDB(dst, b, h) do { _Pragma("unroll") for (int n = 0; n < 2; ++n) _Pragma("unroll") for (int k = 0; k < 2; ++k) dst[n][k] = *(const PG8_LAS bf16x8*)(lds + PG8_SB(b, h) + boff + n * 2048 + k * 1024); } while (0)
#define PG8_MMA(ai, bj, At, Bt) do { __builtin_amdgcn_s_setprio(1); _Pragma("unroll") for (int m = 0; m < 4; ++m) _Pragma("unroll") for (int n = 0; n < 2; ++n) _Pragma("unroll") for (int k = 0; k < 2; ++k) \
        acc[ai][bj][m][n] = __builtin_amdgcn_mfma_f32_16x16x32_bf16(Bt[n][k], At[m][k], acc[ai][bj][m][n], 0, 0, 0); __builtin_amdgcn_s_setprio(0); } while (0)
#define PG8_WAIT_V(n) asm volatile("s_waitcnt vmcnt(" #n ")" ::: "memory")
#define PG8_WAIT_L(n) asm volatile("s_waitcnt lgkmcnt(" #n ")" ::: "memory")
#define PG8_BAR __builtin_amdgcn_s_barrier()
#define PG8_SCHED __builtin_amdgcn_sched_barrier(0)
    Unit cur, nxt; int ui = 0;
    if (!S.next(0, cur)) return;
    f32x4 acc[2][2][4][2];
#pragma unroll
    for (int a = 0; a < 2; ++a)
#pragma unroll
        for (int b = 0; b < 2; ++b)
#pragma unroll
            for (int m = 0; m < 4; ++m)
#pragma unroll
                for (int n = 0; n < 2; ++n) acc[a][b][m][n] = (f32x4){0.f, 0.f, 0.f, 0.f};
    bf16x8 At[4][2], B0[2][2], B1[2][2];
    const char* cA = (const char*)g.A + (size_t)cur.pm * tstep; const char* cB = (const char*)g.Bt + (size_t)cur.pn * tstep;
    S.a_ready(cur);
    if constexpr (SP2) {
        PG8_STAGE(PG8_SB(0, 0), cB, voffB); PG8_STAGE(PG8_SB(0, 1), cB + hstep, voffB); PG8_STAGE(PG8_SA(0, 0), cA, voffA); PG8_STAGE(PG8_SA(0, 1), cA + hstep, voffA);
        if (wr == 1) PG8_BAR;
        PG8_WAIT_V(2); PG8_BAR;
        PG8_STAGE(PG8_SB(1, 0), cB + kstep, voffB); PG8_STAGE(PG8_SA(1, 0), cA + kstep, voffA); PG8_STAGE(PG8_SB(1, 1), cB + hstep + kstep, voffB);
        PG8_WAIT_V(6); PG8_BAR;
    } else {
        PG8_STAGE(PG8_SB(0, 0), cB, voffB); PG8_STAGE(PG8_SA(0, 0), cA, voffA); PG8_STAGE(PG8_SB(0, 1), cB + hstep, voffB); PG8_STAGE(PG8_SA(0, 1), cA + hstep, voffA);
        if (wr == 1) PG8_BAR;
        PG8_WAIT_V(4); PG8_BAR;
        PG8_STAGE(PG8_SB(1, 0), cB + kstep, voffB); PG8_STAGE(PG8_SA(1, 0), cA + kstep, voffA); PG8_STAGE(PG8_SB(1, 1), cB + hstep + kstep, voffB);
        PG8_WAIT_V(6); PG8_BAR;
    }
    for (;;) {
        const bool has_next = S.next(ui + 1, nxt);
        const char* nA = has_next ? (const char*)g.A + (size_t)nxt.pm * tstep : cA; const char* nB = has_next ? (const char*)g.Bt + (size_t)nxt.pn * tstep : cB;
        for (int t = 0; t < nt; t += 2) {
            const bool last = (t == nt - 2);
            const char* a1 = cA + (size_t)(t + 1) * kstep;
            const char* a2 = last ? nA : cA + (size_t)(t + 2) * kstep; const char* b2 = last ? nB : cB + (size_t)(t + 2) * kstep;
            const char* a3 = a2 + kstep; const char* b3 = b2 + kstep;
            if (last && has_next) S.a_ready(nxt);
            if constexpr (SP2) {
            PG8_LDB(B0, 0, 0); PG8_LDB(B1, 0, 1); PG8_SCHED; PG8_LDA(At, 0, 0); PG8_STAGE(PG8_SA(1, 1), a1 + hstep, voffA);
            PG8_WAIT_V(8); PG8_WAIT_L(0); PG8_BAR; PG8_MMA(0, 0, At, B0); PG8_MMA(0, 1, At, B1); PG8_BAR; PG8_SCHED;
            PG8_LDA(At, 0, 1); PG8_STAGE(PG8_SB(0, 0), b2, voffB); PG8_STAGE(PG8_SB(0, 1), b2 + hstep, voffB); PG8_STAGE(PG8_SA(0, 0), a2, voffA);
            PG8_WAIT_V(8); PG8_WAIT_L(0); PG8_BAR; PG8_MMA(1, 0, At, B0); PG8_MMA(1, 1, At, B1); PG8_BAR; PG8_SCHED;
            PG8_LDB(B0, 1, 0); PG8_LDB(B1, 1, 1); PG8_SCHED; PG8_LDA(At, 1, 0); PG8_STAGE(PG8_SA(0, 1), a2 + hstep, voffA);
            PG8_WAIT_V(8); PG8_WAIT_L(0); PG8_BAR; PG8_MMA(0, 0, At, B0); PG8_MMA(0, 1, At, B1); PG8_BAR; PG8_SCHED;
            PG8_LDA(At, 1, 1); PG8_STAGE(PG8_SB(1, 0), b3, voffB); PG8_STAGE(PG8_SB(1, 1), b3 + hstep, voffB); PG8_STAGE(PG8_SA(1, 0), a3, voffA);
            PG8_WAIT_V(8); PG8_WAIT_L(0); PG8_BAR; PG8_MMA(1, 0, At, B0); PG8_MMA(1, 1, At, B1); PG8_BAR; PG8_SCHED;
            } else {
            PG8_LDB(B0, 0, 0); PG8_SCHED; PG8_LDA(At, 0, 0); PG8_STAGE(PG8_SA(1, 1), a1 + hstep, voffA);
            PG8_WAIT_L(8); PG8_BAR; PG8_WAIT_L(0); PG8_MMA(0, 0, At, B0); PG8_BAR; PG8_SCHED;
            PG8_LDB(B1, 0, 1); PG8_STAGE(PG8_SB(0, 0), b2, voffB);
            PG8_BAR; PG8_WAIT_L(0); PG8_MMA(0, 1, At, B1); PG8_BAR;
            PG8_LDA(At, 0, 1); PG8_STAGE(PG8_SA(0, 0), a2, voffA);
            PG8_BAR; PG8_WAIT_L(0); PG8_MMA(1, 0, At, B0); PG8_BAR; PG8_SCHED;
            PG8_STAGE(PG8_SB(0, 1), b2 + hstep, voffB);
            PG8_WAIT_V(6); PG8_BAR; PG8_MMA(1, 1, At, B1); PG8_BAR;
            PG8_LDB(B0, 1, 0); PG8_SCHED; PG8_LDA(At, 1, 0); PG8_STAGE(PG8_SA(0, 1), a2 + hstep, voffA);
            PG8_WAIT_L(8); PG8_BAR; PG8_WAIT_L(0); PG8_MMA(0, 0, At, B0); PG8_BAR; PG8_SCHED;
            PG8_LDB(B1, 1, 1); PG8_STAGE(PG8_SB(1, 0), b3, voffB);
            PG8_BAR; PG8_WAIT_L(0); PG8_MMA(0, 1, At, B1); PG8_BAR;
            PG8_LDA(At, 1, 1); PG8_STAGE(PG8_SA(1, 0), a3, voffA);
            PG8_BAR; PG8_WAIT_L(0); PG8_MMA(1, 0, At, B0); PG8_BAR; PG8_SCHED;
            PG8_STAGE(PG8_SB(1, 1), b3 + hstep, voffB);
            PG8_WAIT_V(6); PG8_BAR; PG8_MMA(1, 1, At, B1); PG8_BAR;
            }
        }
        if constexpr (ALIGN_EPI) { if (wr == 0) PG8_BAR; }
        if constexpr (!Epi::AFTER_DRAIN) { E(acc, cur, wr, wc, fr, fq); S.done(cur); }
        if (!has_next) break;
#pragma unroll
        for (int a = 0; a < 2; ++a)
#pragma unroll
            for (int b = 0; b < 2; ++b)
#pragma unroll
                for (int m = 0; m < 4; ++m)
#pragma unroll
                    for (int n = 0; n < 2; ++n) acc[a][b][m][n] = (f32x4){0.f, 0.f, 0.f, 0.f};
        cur = nxt; cA = nA; cB = nB; ++ui;
        if constexpr (ALIGN_EPI) { if (wr == 1) PG8_BAR; }
    }
    PG8_WAIT_V(0);
    if constexpr (!ALIGN_EPI) { if (wr == 0) PG8_BAR; }
    PG8_BAR;
    if constexpr (Epi::AFTER_DRAIN) { E.fused(acc, cur, wr, wc, fr, fq, lds, wid, lane); S.done(cur); }
#undef PG8_SA
#undef PG8_SB
#undef PG8_STAGE
#undef PG8_LDA
#undef PG8_LDB
#undef PG8_MMA
#undef PG8_WAIT_V
#undef PG8_WAIT_L
#undef PG8_BAR
#undef PG8_SCHED
}
}

#ifndef PG8_SP2
#define PG8_SP2 true
#endif
#ifndef PG8_ALIGN
#define PG8_ALIGN true
#endif
#ifndef MK_N_LAUNCHES
#define MK_N_LAUNCHES 1
#endif

constexpr int NWAVES = 8;
constexpr int NB = 4, S = 4096, D = 1024, M = NB * S;
constexpr int NH = 8, SBW = 512, PJ = 2048, NE = 16, EH = 512;
constexpr float ALPHA = 1.189207115002721f;
constexpr float LN_EPS = 1e-5f;
constexpr float QSCALE = 0.125f * 1.4426950408889634f;
constexpr int N_PHASES = 10;
constexpr int N_LAUNCHES = MK_N_LAUNCHES;
constexpr int SORT_ROWS = 2 * M + NE * 256;

constexpr size_t MiB = 1u << 20;
constexpr size_t WS_CTL = 0, CTL_ZERO_BYTES = 1 * MiB;
constexpr size_t WS_MODP = 1 * MiB;
constexpr size_t WS_MOD = 2 * MiB;
constexpr size_t WS_ROUTE = 4 * MiB;
constexpr size_t WS_WIN = 8 * MiB;
constexpr size_t WS_WOUT = 12 * MiB;
constexpr size_t WS_WGU = 16 * MiB;
constexpr size_t WS_WD = 48 * MiB;
constexpr size_t WS_XN = 64 * MiB;
constexpr size_t WS_Q = 96 * MiB;
constexpr size_t WS_AO = 160 * MiB;
constexpr size_t WS_XS = 96 * MiB;
constexpr size_t WS_HS = 168 * MiB;
constexpr size_t WS_END = 204 * MiB;
static_assert(WS_XS + (size_t)SORT_ROWS * 1024 * 2 <= WS_HS && WS_HS + (size_t)SORT_ROWS * 512 * 2 <= WS_END, "d_ws map");
constexpr int CW_TMO = 0, CW_CODE = 1, CW_BAR = 4096, CW_CNT = 16384;

constexpr int RING_OFF = 0, RING_BYTES = 131072;
constexpr int LDSCTL_OFF = RING_BYTES, MISC_OFF = LDSCTL_OFF + 320;
constexpr int LDS_BYTES = 147456;

#define GAS __attribute__((address_space(1)))
#define LAS __attribute__((address_space(3)))
typedef unsigned short bf16;
typedef unsigned v4u __attribute__((ext_vector_type(4)));
typedef unsigned v2u __attribute__((ext_vector_type(2)));
typedef float f32x4 __attribute__((ext_vector_type(4)));
typedef float f32x16 __attribute__((ext_vector_type(16)));
typedef short bf16x8 __attribute__((ext_vector_type(8)));
typedef short s16x4 __attribute__((ext_vector_type(4)));
typedef GAS unsigned gu32;
#define RLX_AGENT __ATOMIC_RELAXED, __HIP_MEMORY_SCOPE_AGENT
#define LDS_WAIT() asm volatile("s_waitcnt lgkmcnt(0)" ::: "memory")
#define VM_WAIT() asm volatile("s_waitcnt vmcnt(0)" ::: "memory")
__device__ __forceinline__ unsigned f2bf(float f) { unsigned u = __builtin_bit_cast(unsigned, f); return (u + 0x7fffu + ((u >> 16) & 1u)) >> 16; }
__device__ __forceinline__ unsigned pk2(float lo, float hi) { return f2bf(lo) | (f2bf(hi) << 16); }
__device__ __forceinline__ float bf_lo(unsigned w) { return __builtin_bit_cast(float, w << 16); }
__device__ __forceinline__ float bf_hi(unsigned w) { return __builtin_bit_cast(float, w & 0xffff0000u); }

#define XB_TMO      128
#define XB_XCNT(j)  (256  + 64 * (j))
#define XB_XSUB(j)  (1280 + 64 * (j))
#define XB_XGEN(j)  (2304 + 64 * (j))
#define XB_TOP      3328
#define XB_TOPGEN   3392
#define XCD_BAR_WORDS 3456
#define XB_SPIN_CAP (1u << 18)

__device__ __forceinline__ unsigned xb_ld(unsigned* p)              { return __hip_atomic_load(p, __ATOMIC_RELAXED, __HIP_MEMORY_SCOPE_AGENT); }
__device__ __forceinline__ unsigned xb_add(unsigned* p, unsigned v) { return __hip_atomic_fetch_add(p, v, __ATOMIC_RELAXED, __HIP_MEMORY_SCOPE_AGENT); }
__device__ __forceinline__ unsigned xb_xcc_id() { return (unsigned)__builtin_amdgcn_s_getreg((3 << 11) | 20) & 0xFu; }
#define XB_SPIN(cond, bar) do { unsigned _sp = 0; while (cond) { __builtin_amdgcn_s_sleep(1); \
    if ((++_sp & 255u) == 0u) { if (xb_ld(&(bar)[XB_TMO])) break; if (_sp > XB_SPIN_CAP) { atomicAdd(&(bar)[XB_TMO], 1u); break; } } } } while (0)

struct XcdBarrier {
    unsigned* bar; unsigned x;
    volatile LAS unsigned* st;
};

__device__ __forceinline__ XcdBarrier xcd_barrier_post(unsigned* bar, volatile LAS unsigned* st) {
    XcdBarrier b; b.bar = bar; b.x = xb_xcc_id(); b.st = st;
    if (threadIdx.x == 0) (void)xb_add(&bar[XB_XCNT(b.x)], 1u);
    return b;
}
__device__ __forceinline__ void xcd_barrier_complete(unsigned* bar, unsigned x, unsigned& nloc, unsigned& nx) {
    const unsigned G = gridDim.x * gridDim.y * gridDim.z;
    unsigned sum, cnt, mine, sp = 0u;
    for (;;) {
        sum = 0u; cnt = 0u; mine = 0u;
#pragma unroll
        for (unsigned j = 0; j < 16; ++j) { const unsigned c = xb_ld(&bar[XB_XCNT(j)]); sum += c; cnt += (c > 0u) ? 1u : 0u; mine = (j == x) ? c : mine; }
        if (sum == G) break;
        __builtin_amdgcn_s_sleep(1);
        if ((++sp & 255u) == 0u) { if (xb_ld(&bar[XB_TMO])) break; if (sp > XB_SPIN_CAP) { atomicAdd(&bar[XB_TMO], 1u); break; } }
    }
    nloc = mine > 0u ? mine : 1u; nx = cnt > 0u ? cnt : 1u;
}

__device__ __forceinline__ void xcd_barrier(const XcdBarrier& b) {
    asm volatile("s_waitcnt vmcnt(0)" ::: "memory");
    __syncthreads();
    if (threadIdx.x == 0) {
        unsigned* bar = b.bar;
        __builtin_amdgcn_s_waitcnt(0);
        unsigned nloc = b.st[0], nx = b.st[1];
        if (nloc == 0u) { xcd_barrier_complete(bar, b.x, nloc, nx); b.st[0] = nloc; b.st[1] = nx; }
        const unsigned old = xb_add(&bar[XB_XSUB(b.x)], 1u);
        const unsigned gen = old / nloc;
        if (old + 1u == (gen + 1u) * nloc) {
            __builtin_amdgcn_fence(__ATOMIC_RELEASE, "agent");
            asm volatile("s_waitcnt vmcnt(0)" ::: "memory");
            const unsigned og = xb_add(&bar[XB_TOP], 1u);
            const unsigned tg = og / nx;
            if (og + 1u == (tg + 1u) * nx) xb_add(&bar[XB_TOPGEN], 1u);
            else XB_SPIN(xb_ld(&bar[XB_TOPGEN]) == tg, bar);
            __builtin_amdgcn_fence(__ATOMIC_ACQUIRE, "agent");
            xb_add(&bar[XB_XGEN(b.x)], 1u);
            asm volatile("s_waitcnt vmcnt(0)" ::: "memory");
        } else {
            XB_SPIN(xb_ld(&bar[XB_XGEN(b.x)]) == gen, bar);
            __builtin_amdgcn_fence(__ATOMIC_ACQUIRE, "agent");
            asm volatile("s_waitcnt vmcnt(0)" ::: "memory");
        }
    }
    __syncthreads();
}

struct Frame {
    LAS unsigned char* lds;
    volatile LAS unsigned* MISC;
    gu32* ctl;
    int tid, lane, wave, vcu, G;
    const float* in[19]; float* out; unsigned char* ws;
};
__device__ __forceinline__ float wave_sum(float v) {
#pragma unroll
    for (int o = 1; o < 64; o <<= 1) v += __shfl_xor(v, o);
    return v;
}

__device__ __forceinline__ void transpose_item(const float* W, int ldw, int k0, int n0, bf16* WT, size_t drow, int ldd, int dk0, LAS float* scr, int lane) {
#pragma unroll 8
    for (int i = 0; i < 32; ++i) { const int kk = 2 * i + (lane >> 5); scr[kk * 33 + (lane & 31)] = W[(size_t)(k0 + kk) * ldw + n0 + (lane & 31)]; }
    LDS_WAIT(); asm volatile("" ::: "memory");
    const int c = lane & 7;
#pragma unroll
    for (int j = 0; j < 4; ++j) { const int n = (lane >> 3) + 8 * j; const LAS float* s = scr + (8 * c) * 33 + n;
        v4u o; o.x = pk2(s[0 * 33], s[1 * 33]); o.y = pk2(s[2 * 33], s[3 * 33]); o.z = pk2(s[4 * 33], s[5 * 33]); o.w = pk2(s[6 * 33], s[7 * 33]);
        *(GAS v4u*)(WT + (drow + n) * ldd + dk0 + 8 * c) = o; }
    LDS_WAIT(); asm volatile("" ::: "memory");
}
constexpr int I_ADA = 768, I_EFF = 1024, I_WIN = 1024, I_WOUT = 256, I_EXP = 4096;
constexpr int P0_ITEMS = I_ADA + I_EFF + I_WIN + I_WOUT + 3 * I_EXP;
__device__ __forceinline__ void p0_prologue(Frame& F) {
    const float* c = F.in[1]; const float* w_ada = F.in[2]; const float* w_in = F.in[4]; const float* w_pool = F.in[5]; const float* pool_scale = F.in[6];
    const float* w_out = F.in[7]; const float* w_gate = F.in[14]; const float* w_up = F.in[15]; const float* w_down = F.in[16];
    bf16* Win_t = (bf16*)(F.ws + WS_WIN); bf16* Wout_t = (bf16*)(F.ws + WS_WOUT); bf16* Wgu_t = (bf16*)(F.ws + WS_WGU); bf16* Wd_t = (bf16*)(F.ws + WS_WD);
    float* modp = (float*)(F.ws + WS_MODP);
    LAS float* scr = (LAS float*)(F.lds + F.wave * 8704);
    LAS f32x4* sil = (LAS f32x4*)(F.lds + 98304);
    for (int k = F.tid; k < D; k += NWAVES * 64) { f32x4 v;
#pragma unroll
        for (int b = 0; b < 4; ++b) { const float cv = c[b * D + k]; v[b] = cv / (1.f + __expf(-cv)); }
        sil[k] = v; }
    __syncthreads();
    const int gw = F.vcu * NWAVES + F.wave, NGW = F.G * NWAVES, lane = F.lane;
    for (int it = gw; it < P0_ITEMS; it += NGW) {
        int r = it;
        if (r < I_ADA) {
            const int kc = r / 96, ng = r % 96, n = ng * 64 + lane; f32x4 acc = {0.f, 0.f, 0.f, 0.f};
#pragma unroll 8
            for (int k = kc * 128; k < kc * 128 + 128; ++k) { const float wv = w_ada[(size_t)k * 6144 + n]; acc += sil[k] * wv; }
#pragma unroll
            for (int b = 0; b < 4; ++b) modp[(size_t)(kc * 4 + b) * 6144 + n] = acc[b];
            continue; } r -= I_ADA;
        if (r < I_EFF) {
            const int g = r >> 8, nb = (r >> 4) & 15, c0 = (r & 15) * 8, n = nb * 64 + lane; float acc[8];
#pragma unroll
            for (int cc = 0; cc < 8; ++cc) acc[cc] = 0.f;
            for (int e = 0; e < 128; ++e) { const float wo = w_out[(size_t)(512 + g * 128 + e) * 1024 + n] * pool_scale[g * 128 + e];
#pragma unroll
                for (int cc = 0; cc < 8; ++cc) acc[cc] += w_pool[(size_t)(g * 128 + c0 + cc) * 128 + e] * wo; }
            v4u o; o.x = pk2(acc[0], acc[1]); o.y = pk2(acc[2], acc[3]); o.z = pk2(acc[4], acc[5]); o.w = pk2(acc[6], acc[7]);
            *(GAS v4u*)(Wout_t + (size_t)n * 1024 + 512 + g * 128 + c0) = o;
            continue; } r -= I_EFF;
        if (r < I_WIN) { const int kb = r >> 6, nb = r & 63; transpose_item(w_in, PJ, kb * 64, nb * 32, Win_t, (size_t)nb * 32, 1024, kb * 64, scr, lane); continue; } r -= I_WIN;
        if (r < I_WOUT) { const int kb = r >> 5, nb = r & 31; transpose_item(w_out, 1024, kb * 64, nb * 32, Wout_t, (size_t)nb * 32, 1024, kb * 64, scr, lane); continue; } r -= I_WOUT;
        if (r < 2 * I_EXP) { const int up = r >= I_EXP; if (up) r -= I_EXP; const int e = r >> 8, kb = (r >> 4) & 15, nb = r & 15, n0 = nb * 32;
            const float* W = (up ? w_up : w_gate) + (size_t)e * D * EH;
            transpose_item(W, EH, kb * 64, n0, Wgu_t, (size_t)e * 1024 + (n0 >> 7) * 256 + up * 128 + (n0 & 127), 1024, kb * 64, scr, lane); continue; } r -= 2 * I_EXP;
        { const int e = r >> 8, kb = (r >> 5) & 7, nb = r & 31;
            transpose_item(w_down + (size_t)e * EH * D, D, kb * 64, nb * 32, Wd_t, (size_t)e * 1024 + nb * 32, 512, kb * 64, scr, lane); }
    }
}

__device__ __forceinline__ void p1_lnmod(Frame& F) {
    const float* x = F.in[0]; const float* b_ada = F.in[3]; const float* modp = (const float*)(F.ws + WS_MODP); float* mod = (float*)(F.ws + WS_MOD);
    bf16* XN = (bf16*)(F.ws + WS_XN);
    LAS float* sc = (LAS float*)F.lds; LAS float* sh = sc + 1024;
    for (int vb = F.vcu; vb < 256; vb += F.G) {
        const int b = vb >> 6;
        __syncthreads();
        for (int col = F.tid; col < 1024; col += NWAVES * 64) { float a = b_ada[col], s = b_ada[1024 + col];
#pragma unroll
            for (int kc = 0; kc < 8; ++kc) { a += modp[(size_t)(kc * 4 + b) * 6144 + col]; s += modp[(size_t)(kc * 4 + b) * 6144 + 1024 + col]; }
            sh[col] = a; sc[col] = 1.f + s; }
        if (F.tid < 96) { const int n = vb * 96 + F.tid, bb = n / 6144, nn = n % 6144; float a = b_ada[nn];
#pragma unroll
            for (int kc = 0; kc < 8; ++kc) a += modp[(size_t)(kc * 4 + bb) * 6144 + nn];
            mod[n] = a; }
        __syncthreads();
        for (int i = 0; i < 8; ++i) {
            const int m = vb * 64 + F.wave * 8 + i;
            const GAS f32x4* xr = (const GAS f32x4*)(x + (size_t)m * D) + F.lane;
            f32x4 v[4]; float s = 0.f;
#pragma unroll
            for (int j = 0; j < 4; ++j) { v[j] = xr[64 * j]; s += (v[j].x + v[j].y) + (v[j].z + v[j].w); }
            const float mean = wave_sum(s) * (1.f / D); float s2 = 0.f;
#pragma unroll
            for (int j = 0; j < 4; ++j) { v[j] = v[j] - mean; s2 += (v[j].x * v[j].x + v[j].y * v[j].y) + (v[j].z * v[j].z + v[j].w * v[j].w); }
            const float rstd = 1.f / sqrtf(wave_sum(s2) * (1.f / D) + LN_EPS);
            GAS v2u* o8 = (GAS v2u*)(XN + (size_t)m * D) + F.lane;
#pragma unroll
            for (int j = 0; j < 4; ++j) { const f32x4 a = *(const LAS f32x4*)(sc + 256 * j + 4 * F.lane), bsh = *(const LAS f32x4*)(sh + 256 * j + 4 * F.lane);
                const f32x4 o = v[j] * rstd * a + bsh; v2u w; w.x = pk2(o.x, o.y); w.y = pk2(o.z, o.w); o8[64 * j] = w; }
        }
    }
}

__device__ __forceinline__ int crow(int r, int hi) { return (r & 3) + 8 * (r >> 2) + 4 * hi; }
__device__ __forceinline__ s16x4 vtr(const LAS unsigned char* p) { return __builtin_bit_cast(s16x4, __builtin_amdgcn_ds_read_tr16_b64_v4i16((LAS s16x4*)p)); }
#ifndef ATT_EARLY_EXIT
#define ATT_EARLY_EXIT 1
#endif
__device__ __forceinline__ void attn_unit(int b, int h, int qb, const bf16* Q, const bf16* K, const bf16* V, bf16* AO, LAS unsigned char* vl, int lane) {
    const int r32 = lane & 31, hi = lane >> 5, q0 = qb * 32, qabs = q0 + r32; const size_t rowbase = (size_t)b * S;
    const bf16* Qw = Q + (rowbase + q0 + r32) * SBW + h * 64 + hi * 8;
    bf16x8 qr[4];
#pragma unroll
    for (int d0 = 0; d0 < 4; ++d0) qr[d0] = *(const bf16x8*)(Qw + d0 * 16);
    f32x16 o0, o1;
#pragma unroll
    for (int r = 0; r < 16; ++r) { o0[r] = 0.f; o1[r] = 0.f; }
    float R = 1.f;
    const int jmax = q0 >> 6;
    const LAS unsigned char* vp = vl + ((lane >> 4) & 1) * 32 + (lane & 3) * 8 + (4 * hi + ((lane & 15) >> 2)) * 64;
    for (int j = jmax; j >= 0; --j) {
        const bf16* Kt = K + (rowbase + (size_t)j * 64) * SBW + h * 64;
        const bf16* Vt = V + (rowbase + (size_t)j * 64) * SBW + h * 64;
        bf16x8 kf[8]; v4u vv[8];
#pragma unroll
        for (int d0 = 0; d0 < 4; ++d0)
#pragma unroll
            for (int T = 0; T < 2; ++T) kf[d0 * 2 + T] = *(const bf16x8*)(Kt + (size_t)(32 * T + r32) * SBW + (2 * d0 + hi) * 8);
#pragma unroll
        for (int i = 0; i < 8; ++i) vv[i] = *(const v4u*)(Vt + (size_t)(i * 8 + (lane >> 3)) * SBW + (lane & 7) * 8);
#pragma unroll
        for (int i = 0; i < 8; ++i) { const int row = i * 8 + (lane >> 3), ch = lane & 7;
            *(LAS v4u*)(vl + (ch >> 2) * 4096 + (row >> 4) * 1024 + (row & 15) * 64 + (ch & 3) * 16) = vv[i]; }
        f32x16 p0, p1;
#pragma unroll
        for (int r = 0; r < 16; ++r) { p0[r] = 0.f; p1[r] = 0.f; }
#pragma unroll
        for (int d0 = 0; d0 < 4; ++d0) { p0 = __builtin_amdgcn_mfma_f32_32x32x16_bf16(kf[2 * d0], qr[d0], p0, 0, 0, 0); p1 = __builtin_amdgcn_mfma_f32_32x32x16_bf16(kf[2 * d0 + 1], qr[d0], p1, 0, 0, 0); }
        f32x16 be0, be1;
#pragma unroll
        for (int r = 0; r < 16; ++r) {
            { const float z = p0[r], t = __builtin_amdgcn_exp2f(-__builtin_fabsf(z)), rr = __builtin_amdgcn_rcpf(1.f + t), tr = t * rr; const bool pos = z >= 0.f; be0[r] = pos ? rr : tr; p0[r] = pos ? tr : rr; }
            { const float z = p1[r], t = __builtin_amdgcn_exp2f(-__builtin_fabsf(z)), rr = __builtin_amdgcn_rcpf(1.f + t), tr = t * rr; const bool pos = z >= 0.f; be1[r] = pos ? rr : tr; p1[r] = pos ? tr : rr; }
        }
        if (j == jmax) {
#pragma unroll
            for (int r = 0; r < 16; ++r) { const int k0 = 64 * j + crow(r, hi);
                if (k0 >= qabs) { be0[r] = 0.f; p0[r] = 1.f; }
                if (k0 + 32 >= qabs) { be1[r] = 0.f; p1[r] = 1.f; } }
        }
#define SB_GROUP(P, BE, g) do { const float w0 = P[4 * (g)], w1 = P[4 * (g) + 1], w2 = P[4 * (g) + 2], w3 = P[4 * (g) + 3]; \
            const float G = ((w3 * w2) * w1) * w0; \
            auto sw = __builtin_amdgcn_permlane32_swap(__float_as_uint(G), __float_as_uint(G), false, false); \
            const float Glo = __uint_as_float(sw[0]), Ghi = __uint_as_float(sw[1]); \
            const float off = hi ? R : R * Ghi; \
            const float o2 = off * w3, o1_ = o2 * w2, o0_ = o1_ * w1; \
            P[4 * (g) + 3] = BE[4 * (g) + 3] * off; P[4 * (g) + 2] = BE[4 * (g) + 2] * o2; P[4 * (g) + 1] = BE[4 * (g) + 1] * o1_; P[4 * (g)] = BE[4 * (g)] * o0_; \
            R = R * (Glo * Ghi); } while (0)
        SB_GROUP(p1, be1, 3); SB_GROUP(p1, be1, 2); SB_GROUP(p1, be1, 1); SB_GROUP(p1, be1, 0);
        SB_GROUP(p0, be0, 3); SB_GROUP(p0, be0, 2); SB_GROUP(p0, be0, 1); SB_GROUP(p0, be0, 0);
#undef SB_GROUP
        bf16x8 pa[4];
        { v4u w;
          w.x = pk2(p0[0], p0[1]); w.y = pk2(p0[2], p0[3]); w.z = pk2(p0[4], p0[5]); w.w = pk2(p0[6], p0[7]); pa[0] = __builtin_bit_cast(bf16x8, w);
          w.x = pk2(p0[8], p0[9]); w.y = pk2(p0[10], p0[11]); w.z = pk2(p0[12], p0[13]); w.w = pk2(p0[14], p0[15]); pa[1] = __builtin_bit_cast(bf16x8, w);
          w.x = pk2(p1[0], p1[1]); w.y = pk2(p1[2], p1[3]); w.z = pk2(p1[4], p1[5]); w.w = pk2(p1[6], p1[7]); pa[2] = __builtin_bit_cast(bf16x8, w);
          w.x = pk2(p1[8], p1[9]); w.y = pk2(p1[10], p1[11]); w.z = pk2(p1[12], p1[13]); w.w = pk2(p1[14], p1[15]); pa[3] = __builtin_bit_cast(bf16x8, w); }
#pragma unroll
        for (int ks = 0; ks < 4; ++ks) {
            const s16x4 l0 = vtr(vp + ks * 1024), h0 = vtr(vp + ks * 1024 + 512), l1 = vtr(vp + 4096 + ks * 1024), h1 = vtr(vp + 4096 + ks * 1024 + 512);
            const bf16x8 f0 = {l0[0], l0[1], l0[2], l0[3], h0[0], h0[1], h0[2], h0[3]}, f1 = {l1[0], l1[1], l1[2], l1[3], h1[0], h1[1], h1[2], h1[3]};
            o0 = __builtin_amdgcn_mfma_f32_32x32x16_bf16(pa[ks], f0, o0, 0, 0, 0);
            o1 = __builtin_amdgcn_mfma_f32_32x32x16_bf16(pa[ks], f1, o1, 0, 0, 0);
        }
#if ATT_EARLY_EXIT
        if (__all(R < 1.17549435e-38f)) break;
#endif
    }
    bf16* Ow = AO + (rowbase + q0) * D + h * 64 + r32;
#pragma unroll
    for (int r = 0; r < 16; ++r) { const int q = crow(r, hi); Ow[(size_t)q * D] = (bf16)f2bf(o0[r]); Ow[(size_t)q * D + 32] = (bf16)f2bf(o1[r]); }
}
__device__ __forceinline__ void pool_item(int it, const bf16* P, bf16* AO, int lane) {
    const int m0 = it * 32, t0 = m0 & (S - 1), w = 2 << (lane >> 4);
    const bf16* Pc = P + lane * 8; float s[8];
#pragma unroll
    for (int i = 0; i < 8; ++i) s[i] = 0.f;
    for (int k = 15; k >= 1; --k) if (k < w && t0 - k >= 0) { const v4u v = *(const v4u*)(Pc + (size_t)(m0 - k) * SBW);
        s[0] += bf_lo(v.x); s[1] += bf_hi(v.x); s[2] += bf_lo(v.y); s[3] += bf_hi(v.y); s[4] += bf_lo(v.z); s[5] += bf_hi(v.z); s[6] += bf_lo(v.w); s[7] += bf_hi(v.w); }
    for (int r = 0; r < 32; ++r) {
        const int m = m0 + r, t = t0 + r;
        const v4u v = *(const v4u*)(Pc + (size_t)m * SBW);
        const float cur[8] = {bf_lo(v.x), bf_hi(v.x), bf_lo(v.y), bf_hi(v.y), bf_lo(v.z), bf_hi(v.z), bf_lo(v.w), bf_hi(v.w)};
#pragma unroll
        for (int i = 0; i < 8; ++i) s[i] += cur[i];
        const float inv = 1.f / (float)((t + 1 < w) ? t + 1 : w);
        v4u o; o.x = pk2(s[0] * inv - cur[0], s[1] * inv - cur[1]); o.y = pk2(s[2] * inv - cur[2], s[3] * inv - cur[3]);
        o.z = pk2(s[4] * inv - cur[4], s[5] * inv - cur[5]); o.w = pk2(s[6] * inv - cur[6], s[7] * inv - cur[7]);
        *(GAS v4u*)(AO + (size_t)m * D + 512 + lane * 8) = o;
        if (t - w + 1 >= 0) { const v4u u = *(const v4u*)(Pc + (size_t)(m - w + 1) * SBW);
            s[0] -= bf_lo(u.x); s[1] -= bf_hi(u.x); s[2] -= bf_lo(u.y); s[3] -= bf_hi(u.y); s[4] -= bf_lo(u.z); s[5] -= bf_hi(u.z); s[6] -= bf_lo(u.w); s[7] -= bf_hi(u.w); }
    }
}
__device__ __forceinline__ void p3_attn_pool(Frame& F) {
    const bf16* Q = (const bf16*)(F.ws + WS_Q); const bf16* K = Q + (size_t)M * SBW; const bf16* V = K + (size_t)M * SBW; const bf16* P = V + (size_t)M * SBW;
    bf16* AO = (bf16*)(F.ws + WS_AO);
    const int gw = F.vcu * NWAVES + F.wave, NGW = F.G * NWAVES;
    LAS unsigned char* vl = F.lds + F.wave * 8192;
    for (int uid = gw; uid < NB * NH * (S / 32); uid += NGW) attn_unit(uid >> 10, (uid >> 7) & 7, uid & 127, Q, K, V, AO, vl, F.lane);
    for (int it = gw; it < 4 * (M / 32); it += NGW) if ((it & 3) == 0) pool_item(it >> 2, P, AO, F.lane);
}

__device__ __forceinline__ void moe_tiles(Frame& F, int& tstart, int& tend, int& total) {
    const int n = F.lane < 16 ? (int)__hip_atomic_load(F.ctl + CW_CNT + 64 * F.lane, RLX_AGENT) : 0;
    const int tiles = (n + 255) >> 8; int incl = tiles;
#pragma unroll
    for (int o = 1; o < 16; o <<= 1) { const int v = __shfl_up(incl, o); if (F.lane >= o) incl += v; }
    tend = F.lane < 16 ? incl : 0x7fffffff; tstart = incl - tiles; total = __builtin_amdgcn_readlane(incl, 15);
}

__device__ __forceinline__ void p5_post(Frame& F) {
    const float* ln1_g = F.in[8]; const float* ln1_b = F.in[9]; const float* w_rg = F.in[10]; const float* b_rg = F.in[11]; const float* w_re = F.in[12]; const float* b_re = F.in[13];
    const float* mod = (const float*)(F.ws + WS_MOD); bf16* U2 = (bf16*)(F.ws + WS_XN); unsigned* route = (unsigned*)(F.ws + WS_ROUTE);
    LAS f32x4* Wl = (LAS f32x4*)F.lds;
    LAS int* asg = (LAS int*)(F.lds + 81920);
    LAS int* rnk = asg + 128; LAS int* lcnt = rnk + 128; LAS int* lbase = lcnt + 16; LAS float* wts = (LAS float*)(lbase + 16);
    for (int idx = F.tid; idx < 5 * 1024; idx += NWAVES * 64) { const int j5 = idx >> 10, col = idx & 1023;
        const f32x4 v = (j5 == 0) ? *(const f32x4*)(w_rg + col * 4) : *(const f32x4*)(w_re + col * 16 + (j5 - 1) * 4);
        Wl[j5 * 1024 + ((col >> 8) * 4 + (col & 3)) * 64 + ((col >> 2) & 63)] = v; }
    for (int vb = F.vcu; vb < 256; vb += F.G) {
        const int b = vb >> 6;
        if (F.tid < 16) lcnt[F.tid] = 0;
        __syncthreads();
        f32x4 g1[4], b1[4], s2[4], h2[4];
#pragma unroll
        for (int j = 0; j < 4; ++j) { g1[j] = ((const f32x4*)ln1_g)[64 * j + F.lane]; b1[j] = ((const f32x4*)ln1_b)[64 * j + F.lane];
            s2[j] = ((const f32x4*)(mod + b * 6144 + 4096))[64 * j + F.lane] + 1.0f; h2[j] = ((const f32x4*)(mod + b * 6144 + 3072))[64 * j + F.lane]; }
        for (int i = 0; i < 8; ++i) {
            const int m = vb * 64 + F.wave * 8 + i;
            GAS f32x4* yr = (GAS f32x4*)(F.out + (size_t)m * D) + F.lane;
            f32x4 v[4]; float s = 0.f;
#pragma unroll
            for (int j = 0; j < 4; ++j) { v[j] = yr[64 * j]; s += (v[j].x + v[j].y) + (v[j].z + v[j].w); }
            float mean = wave_sum(s) * (1.f / D), q = 0.f;
#pragma unroll
            for (int j = 0; j < 4; ++j) { v[j] = v[j] - mean; q += (v[j].x * v[j].x + v[j].y * v[j].y) + (v[j].z * v[j].z + v[j].w * v[j].w); }
            float rstd = 1.f / sqrtf(wave_sum(q) * (1.f / D) + LN_EPS);
            s = 0.f;
#pragma unroll
            for (int j = 0; j < 4; ++j) { v[j] = v[j] * rstd * g1[j] + b1[j]; yr[64 * j] = v[j]; s += (v[j].x + v[j].y) + (v[j].z + v[j].w); }
            mean = wave_sum(s) * (1.f / D); q = 0.f;
#pragma unroll
            for (int j = 0; j < 4; ++j) { v[j] = v[j] - mean; q += (v[j].x * v[j].x + v[j].y * v[j].y) + (v[j].z * v[j].z + v[j].w * v[j].w); }
            rstd = 1.f / sqrtf(wave_sum(q) * (1.f / D) + LN_EPS);
            GAS v2u* o8 = (GAS v2u*)(U2 + (size_t)m * D) + F.lane;
            float pl[20];
#pragma unroll
            for (int t = 0; t < 20; ++t) pl[t] = 0.f;
#pragma unroll
            for (int j = 0; j < 4; ++j) { v[j] = v[j] * rstd * s2[j] + h2[j]; v2u w; w.x = pk2(v[j].x, v[j].y); w.y = pk2(v[j].z, v[j].w); o8[64 * j] = w;
#pragma unroll
                for (int i4 = 0; i4 < 4; ++i4) { const float uu = v[j][i4];
#pragma unroll
                    for (int j5 = 0; j5 < 5; ++j5) { const f32x4 wv = Wl[j5 * 1024 + (j * 4 + i4) * 64 + F.lane];
                        pl[j5 * 4 + 0] += uu * wv.x; pl[j5 * 4 + 1] += uu * wv.y; pl[j5 * 4 + 2] += uu * wv.z; pl[j5 * 4 + 3] += uu * wv.w; } } }
#pragma unroll
            for (int t = 0; t < 20; ++t) pl[t] = wave_sum(pl[t]);
            if (F.lane == 0) {
                float gl[4], el[16];
#pragma unroll
                for (int t = 0; t < 4; ++t) gl[t] = pl[t] + b_rg[t];
#pragma unroll
                for (int t = 0; t < 16; ++t) el[t] = pl[4 + t] + b_re[t];
                int gi = 0; float gm = gl[0];
#pragma unroll
                for (int t = 1; t < 4; ++t) if (gl[t] > gm) { gm = gl[t]; gi = t; }
                float den = 0.f;
#pragma unroll
                for (int t = 0; t < 4; ++t) den += __expf(gl[t] - gm);
                const float gp = 1.f / den;
                float es[4];
#pragma unroll
                for (int t = 0; t < 4; ++t) es[t] = gi == 0 ? el[t] : gi == 1 ? el[4 + t] : gi == 2 ? el[8 + t] : el[12 + t];
                int i1 = 0; float v1 = es[0];
#pragma unroll
                for (int t = 1; t < 4; ++t) if (es[t] > v1) { v1 = es[t]; i1 = t; }
                int i2 = 0; float v2 = -INFINITY;
#pragma unroll
                for (int t = 0; t < 4; ++t) if (t != i1 && es[t] > v2) { v2 = es[t]; i2 = t; }
                const float e2 = __expf(v2 - v1), w1 = gp / (1.f + e2), w2 = gp * e2 / (1.f + e2);
                const int a = (F.wave * 8 + i) * 2;
                asg[a] = gi * 4 + i1; asg[a + 1] = gi * 4 + i2; wts[a] = w1; wts[a + 1] = w2;
            }
        }
        __syncthreads();
        if (F.tid < 128) rnk[F.tid] = atomicAdd((int*)&lcnt[asg[F.tid]], 1);
        __syncthreads();
        if (F.tid < 16) lbase[F.tid] = (int)__hip_atomic_fetch_add(F.ctl + CW_CNT + 64 * F.tid, (unsigned)lcnt[F.tid], RLX_AGENT);
        __syncthreads();
        if (F.tid < 128) { const int m = vb * 64 + (F.tid >> 1), k = F.tid & 1, e = asg[F.tid];
            route[(size_t)m * 8 + 2 * k] = (unsigned)e; route[(size_t)m * 8 + 2 * k + 1] = (unsigned)(lbase[e] + rnk[F.tid]); route[(size_t)m * 8 + 4 + k] = __float_as_uint(wts[F.tid]); }
        __syncthreads();
    }
}

__device__ __forceinline__ void p6_gather(Frame& F) {
    const bf16* U2 = (const bf16*)(F.ws + WS_XN); bf16* XS = (bf16*)(F.ws + WS_XS); const unsigned* route = (const unsigned*)(F.ws + WS_ROUTE);
    int tstart, tend, total; moe_tiles(F, tstart, tend, total);
    const int gw = F.vcu * NWAVES + F.wave, NGW = F.G * NWAVES;
    for (int m = gw; m < M; m += NGW) {
        const v4u rt = *(const v4u*)(route + (size_t)m * 8);
        const int r1 = __shfl(tstart, (int)rt.x) * 256 + (int)rt.y, r2 = __shfl(tstart, (int)rt.z) * 256 + (int)rt.w;
        const GAS v4u* src = (const GAS v4u*)(U2 + (size_t)m * D) + F.lane;
        const v4u a = src[0], c = src[64];
        GAS v4u* d1 = (GAS v4u*)(XS + (size_t)r1 * D) + F.lane; GAS v4u* d2 = (GAS v4u*)(XS + (size_t)r2 * D) + F.lane;
        d1[0] = a; d1[64] = c; d2[0] = a; d2[64] = c;
    }
}

__device__ __forceinline__ void p9_final(Frame& F) {
    const float* ln2_g = F.in[17]; const float* ln2_b = F.in[18]; const float* mod = (const float*)(F.ws + WS_MOD);
    const bf16* YS = (const bf16*)(F.ws + WS_XS); const unsigned* route = (const unsigned*)(F.ws + WS_ROUTE);
    int tstart, tend, total; moe_tiles(F, tstart, tend, total);
    const int gw = F.vcu * NWAVES + F.wave, NGW = F.G * NWAVES;
    f32x4 g2[4], b2[4];
#pragma unroll
    for (int j = 0; j < 4; ++j) { g2[j] = ((const f32x4*)ln2_g)[64 * j + F.lane]; b2[j] = ((const f32x4*)ln2_b)[64 * j + F.lane]; }
    for (int m = gw; m < M; m += NGW) {
        const int b = m >> 12;
        const v4u rt = *(const v4u*)(route + (size_t)m * 8); const v2u wt = *(const v2u*)(route + (size_t)m * 8 + 4);
        const float w1 = __uint_as_float(wt.x), w2 = __uint_as_float(wt.y);
        const int r1 = __shfl(tstart, (int)rt.x) * 256 + (int)rt.y, r2 = __shfl(tstart, (int)rt.z) * 256 + (int)rt.w;
        GAS f32x4* xr = (GAS f32x4*)(F.out + (size_t)m * D) + F.lane;
        const GAS v2u* y1 = (const GAS v2u*)(YS + (size_t)r1 * D) + F.lane; const GAS v2u* y2 = (const GAS v2u*)(YS + (size_t)r2 * D) + F.lane;
        f32x4 v[4]; float s = 0.f;
#pragma unroll
        for (int j = 0; j < 4; ++j) { const f32x4 xv = xr[64 * j]; const v2u a = y1[64 * j], c = y2[64 * j];
            const f32x4 gt = ((const f32x4*)(mod + b * 6144 + 5120))[64 * j + F.lane] + 1.0f;
            f32x4 y; y.x = w1 * bf_lo(a.x) + w2 * bf_lo(c.x); y.y = w1 * bf_hi(a.x) + w2 * bf_hi(c.x); y.z = w1 * bf_lo(a.y) + w2 * bf_lo(c.y); y.w = w1 * bf_hi(a.y) + w2 * bf_hi(c.y);
            v[j] = xv * ALPHA + gt * y; s += (v[j].x + v[j].y) + (v[j].z + v[j].w); }
        const float mean = wave_sum(s) * (1.f / D); float q = 0.f;
#pragma unroll
        for (int j = 0; j < 4; ++j) { v[j] = v[j] - mean; q += (v[j].x * v[j].x + v[j].y * v[j].y) + (v[j].z * v[j].z + v[j].w * v[j].w); }
        const float rstd = 1.f / sqrtf(wave_sum(q) * (1.f / D) + LN_EPS);
#pragma unroll
        for (int j = 0; j < 4; ++j) xr[64 * j] = v[j] * rstd * g2[j] + b2[j];
    }
}

struct Args { const float* in[19]; float* out; unsigned char* ws; int ph_lo, ph_hi, li, pad; };
__global__ void __launch_bounds__(NWAVES * 64, 2) mk_fwd(Args args) {
    extern __shared__ __attribute__((aligned(16))) unsigned char lds[];
    Frame F;
    F.lds = (LAS unsigned char*)lds;
    F.MISC = (volatile LAS unsigned*)(F.lds + MISC_OFF);
    F.tid = threadIdx.x; F.lane = F.tid & 63; F.wave = __builtin_amdgcn_readfirstlane(F.tid >> 6);
    F.G = gridDim.x; { const int bx = blockIdx.x; F.vcu = (F.G % 8 == 0) ? (bx % 8) * (F.G / 8) + bx / 8 : bx; }
    F.ws = args.ws; F.out = args.out; F.ctl = (gu32*)(args.ws + WS_CTL);
#pragma unroll
    for (int i = 0; i < 19; ++i) F.in[i] = args.in[i];
    for (int u = F.tid; u < (LDS_BYTES - LDSCTL_OFF) / 4; u += NWAVES * 64) ((LAS unsigned*)(F.lds + LDSCTL_OFF))[u] = 0u;
    __syncthreads();
    XcdBarrier bar; bar.bar = (unsigned*)(F.ctl + CW_BAR); bar.x = 0; bar.st = nullptr;
    if (N_LAUNCHES == 1) bar = xcd_barrier_post((unsigned*)(F.ctl + CW_BAR), F.MISC + 8);
#define GRID_BAR() do { if (N_LAUNCHES == 1) xcd_barrier(bar); } while (0)
    const int lo = args.ph_lo, hi = args.ph_hi;
#define IN(k) (lo <= (k) && (k) < hi)
#define BOTH(k) (IN(k) && IN((k) + 1))
    bf16* XN = (bf16*)(F.ws + WS_XN);
    if (IN(0)) { p0_prologue(F); if (BOTH(0)) GRID_BAR(); }
    if (IN(1)) { p1_lnmod(F); if (BOTH(1)) GRID_BAR(); }
    if (IN(2)) {
        __syncthreads();
        pg8::Gemm g{XN, (const bf16*)(F.ws + WS_WIN), M, PJ, D}; pg8::StaticOrder So; So.init(M, PJ, F.G, (int)blockIdx.x);
        pg8::EpiQKVP E{(bf16*)(F.ws + WS_Q), (size_t)M * SBW, QSCALE};
        pg8::gemm_phase<pg8::EpiQKVP, pg8::StaticOrder, PG8_ALIGN, PG8_SP2>(F.lds + RING_OFF, g, So, E);
        if (BOTH(2)) GRID_BAR();
    }
    if (IN(3)) { __syncthreads(); p3_attn_pool(F); if (BOTH(3)) GRID_BAR(); }
    if (IN(4)) {
        __syncthreads();
        pg8::Gemm g{(const bf16*)(F.ws + WS_AO), (const bf16*)(F.ws + WS_WOUT), M, D, D}; pg8::StaticOrder So; So.init(M, D, F.G, (int)blockIdx.x);
        pg8::EpiY1 E{F.in[0], F.out, (const float*)(F.ws + WS_MOD) + 2048, ALPHA};
        pg8::gemm_phase<pg8::EpiY1, pg8::StaticOrder, PG8_ALIGN, PG8_SP2>(F.lds + RING_OFF, g, So, E);
        if (BOTH(4)) GRID_BAR();
    }
    if (IN(5)) { __syncthreads(); p5_post(F); if (BOTH(5)) GRID_BAR(); }
    if (IN(6)) { p6_gather(F); if (BOTH(6)) GRID_BAR(); }
    if (IN(7)) {
        __syncthreads();
        int tstart, tend, total; moe_tiles(F, tstart, tend, total);
        pg8::Gemm g{(const bf16*)(F.ws + WS_XS), (const bf16*)(F.ws + WS_WGU), SORT_ROWS, NE * 1024, D};
        pg8::MoeOrder So{tend, total, F.G, F.vcu, F.lane};
        pg8::EpiGateUp E{(bf16*)(F.ws + WS_HS)};
        pg8::gemm_phase<pg8::EpiGateUp, pg8::MoeOrder, PG8_ALIGN, PG8_SP2>(F.lds + RING_OFF, g, So, E);
        if (BOTH(7)) GRID_BAR();
    }
    if (IN(8)) {
        __syncthreads();
        int tstart, tend, total; moe_tiles(F, tstart, tend, total);
        pg8::Gemm g{(const bf16*)(F.ws + WS_HS), (const bf16*)(F.ws + WS_WD), SORT_ROWS, NE * 1024, EH};
        pg8::MoeOrder So{tend, total, F.G, F.vcu, F.lane};
        pg8::EpiDown E{(bf16*)(F.ws + WS_XS)};
        pg8::gemm_phase<pg8::EpiDown, pg8::MoeOrder, PG8_ALIGN, PG8_SP2>(F.lds + RING_OFF, g, So, E);
        if (BOTH(8)) GRID_BAR();
    }
    if (IN(9)) { p9_final(F); }
#undef IN
#undef BOTH
}

extern "C" void kernel_launch(void* const* d_in, const int* in_sizes, int n_in, void* d_out, int out_size, void* d_ws, size_t ws_size, hipStream_t stream) {
    static int grid = 0;
    if (grid == 0) {
        if (n_in != 19 || in_sizes[0] != M * D || out_size != M * D || ws_size < WS_END) { fprintf(stderr, "kernel_launch: unexpected problem (n_in %d, out %d, ws %zu); nothing launched\n", n_in, out_size, ws_size); grid = -1; return; }
        int dev = 0, cus = 0, per_cu = 0;
        if (hipGetDevice(&dev) != hipSuccess || hipDeviceGetAttribute(&cus, hipDeviceAttributeMultiprocessorCount, dev) != hipSuccess) { fprintf(stderr, "kernel_launch: device query failed\n"); grid = -1; return; }
        if (hipFuncSetAttribute((const void*)mk_fwd, hipFuncAttributeMaxDynamicSharedMemorySize, LDS_BYTES) != hipSuccess) { fprintf(stderr, "kernel_launch: hipFuncSetAttribute failed\n"); grid = -1; return; }
        if (hipOccupancyMaxActiveBlocksPerMultiprocessor(&per_cu, (const void*)mk_fwd, NWAVES * 64, LDS_BYTES) != hipSuccess || per_cu < 1) { fprintf(stderr, "kernel_launch: occupancy query says %d workgroups per CU; nothing launched\n", per_cu); (void)hipGetLastError(); grid = -1; return; }
        grid = cus;
    }
    if (grid < 0) return;
    if (hipMemsetAsync((char*)d_ws + WS_CTL, 0, CTL_ZERO_BYTES, stream) != hipSuccess) { fprintf(stderr, "kernel_launch: memset failed\n"); return; }
    Args a{};
    for (int i = 0; i < 19; ++i) a.in[i] = (const float*)d_in[i];
    a.out = (float*)d_out; a.ws = (unsigned char*)d_ws;
    for (int li = 0; li < N_LAUNCHES; ++li) {
        a.ph_lo = (N_LAUNCHES == 1) ? 0 : li; a.ph_hi = (N_LAUNCHES == 1) ? N_PHASES : li + 1; a.li = li;
        hipLaunchKernelGGL(mk_fwd, dim3(grid), dim3(NWAVES * 64), LDS_BYTES, stream, a);
        const hipError_t le = hipPeekAtLastError();
        if (le != hipSuccess) { fprintf(stderr, "kernel_launch: launch %d failed: %s\n", li, hipGetErrorName(le)); break; }
    }
}
```

```cpp
#include <hip/hip_runtime.h>
#include <cstdio>
#include <cstdint>
#include <cmath>
namespace pg8 {
#define PG8_LAS __attribute__((address_space(3)))
typedef unsigned short bf16_t;
typedef short bf16x8 __attribute__((ext_vector_type(8)));
typedef float f32x4 __attribute__((ext_vector_type(4)));
typedef unsigned u32x4 __attribute__((ext_vector_type(4)));
constexpr int BM = 256, BK = 64, HALF = 128, HTB = HALF * BK * 2  , STAGE_BYTES = 8 * HTB, NXCD = 8, WGM = 8;

__host__ __device__ __forceinline__ int lds_byte(int r, int c) { const int st = (r >> 4) * 2 + (c >> 5), rr = r & 15, cc = c & 31, ob = rr * 64 + cc * 2; return st * 1024 + (ob ^ (((ob >> 9) & 1) << 5)); }
__host__ __device__ __forceinline__ void stage_rc(int b, int& R, int& C) { const int st = b / 1024, sb = b % 1024, swz = sb ^ (((sb >> 9) & 1) << 5); R = (st >> 1) * 16 + swz / 64; C = (st & 1) * 32 + (swz % 64) / 2; }
__host__ __device__ __forceinline__ int perm32(int rho) { const int n = rho >> 4, i = rho & 15; return 8 * (i >> 2) + 4 * n + (i & 3); }

struct Unit { int pm, pn; };
struct Gemm { const bf16_t* A; const bf16_t* Bt; int M, N, K; };

struct StaticOrder {
    int nM, nN, nwg, G, c;
    __host__ __device__ void init(int M, int N, int G_, int c_) { nM = M / BM; nN = N / BM; nwg = nM * nN; G = G_; c = c_; }
    __host__ __device__ bool next(int i, Unit& u) const {
        const long L = (long)i * G + c; if (L >= nwg) return false;
        int wgid = (int)L; { const int q = nwg / NXCD, r = nwg % NXCD, xcd = wgid % NXCD, off = wgid / NXCD; wgid = (xcd < r ? xcd * (q + 1) : r * (q + 1) + (xcd - r) * q) + off; }
        const int nig = WGM * nN, gid = wgid / nig, fm = gid * WGM, gsz = (nM - fm) < WGM ? (nM - fm) : WGM;
        u.pm = fm + ((wgid % nig) % gsz); u.pn = (wgid % nig) / gsz; return true;
    }
    __device__ __forceinline__ void a_ready(const Unit&) const {}
    __device__ __forceinline__ void done(const Unit&) const {}
};


__device__ __forceinline__ unsigned cvt_pk_bf16(float lo, float hi) { unsigned r; asm volatile("v_cvt_pk_bf16_f32 %0, %1, %2" : "=v"(r) : "v"(lo), "v"(hi)); return r; }

struct EpiQKVP {
    static constexpr bool PERM = true, AFTER_DRAIN = false;
    bf16_t* O; size_t split_stride; float scale0;
    __device__ __forceinline__ void operator()(const f32x4 (&acc)[2][2][4][2], const Unit& u, int wr, int wc, int fr, int fq) const {
        const int row0 = u.pm * BM + wr * 64 + fr; const int t = u.pn >> 1; const int colt = (u.pn & 1) * BM;
        bf16_t* base = O + (size_t)t * split_stride; const float sc = (t == 0) ? scale0 : 1.f;
        const int col0 = colt + wc * 32 + 8 * fq;
#pragma unroll
        for (int ai = 0; ai < 2; ++ai)
#pragma unroll
            for (int m = 0; m < 4; ++m) { bf16_t* rowp = base + (size_t)(row0 + ai * HALF + m * 16) * 512 + col0;
#pragma unroll
                for (int bj = 0; bj < 2; ++bj) { const f32x4 v0 = acc[ai][bj][m][0] * sc, v1 = acc[ai][bj][m][1] * sc;
                    u32x4 w; w.x = cvt_pk_bf16(v0[0], v0[1]); w.y = cvt_pk_bf16(v0[2], v0[3]); w.z = cvt_pk_bf16(v1[0], v1[1]); w.w = cvt_pk_bf16(v1[2], v1[3]);
                    *(u32x4*)(rowp + bj * HALF) = w; } }
    }
};
struct EpiMix {
    static constexpr bool PERM = true, AFTER_DRAIN = false;
    bf16_t* O; const float* gate;
    __device__ __forceinline__ void operator()(const f32x4 (&acc)[2][2][4][2], const Unit& u, int wr, int wc, int fr, int fq) const {
        const int row0 = u.pm * BM + wr * 64 + fr, col0 = u.pn * BM + wc * 32 + 8 * fq;
        const int b = (u.pm * BM) >> 12;
        f32x4 gv[2][2];
#pragma unroll
        for (int bj = 0; bj < 2; ++bj)
#pragma unroll
            for (int n = 0; n < 2; ++n) gv[bj][n] = *(const f32x4*)(gate + b * 6144 + col0 + bj * HALF + 4 * n) + 1.0f;
#pragma unroll
        for (int ai = 0; ai < 2; ++ai)
#pragma unroll
            for (int m = 0; m < 4; ++m) { bf16_t* rowp = O + (size_t)(row0 + ai * HALF + m * 16) * 1024 + col0;
#pragma unroll
                for (int bj = 0; bj < 2; ++bj) { const f32x4 v0 = acc[ai][bj][m][0] * gv[bj][0], v1 = acc[ai][bj][m][1] * gv[bj][1];
                    u32x4 w; w.x = cvt_pk_bf16(v0[0], v0[1]); w.y = cvt_pk_bf16(v0[2], v0[3]); w.z = cvt_pk_bf16(v1[0], v1[1]); w.w = cvt_pk_bf16(v1[2], v1[3]);
                    *(u32x4*)(rowp + bj * HALF) = w; } }
    }
};
__device__ __forceinline__ float silu_f(float g) { return g * __builtin_amdgcn_rcpf(1.0f + __builtin_amdgcn_exp2f(g * -1.4426950408889634f)); }
struct EpiGateUp {
    static constexpr bool PERM = true, AFTER_DRAIN = false;
    bf16_t* H;
    __device__ __forceinline__ void operator()(const f32x4 (&acc)[2][2][4][2], const Unit& u, int wr, int wc, int fr, int fq) const {
        const int row0 = u.pm * BM + wr * 64 + fr, col0 = (u.pn & 3) * 128 + wc * 32 + 8 * fq;
#pragma unroll
        for (int ai = 0; ai < 2; ++ai)
#pragma unroll
            for (int m = 0; m < 4; ++m) { bf16_t* rowp = H + (size_t)(row0 + ai * HALF + m * 16) * 512 + col0;
                const f32x4 g0 = acc[ai][0][m][0], g1 = acc[ai][0][m][1], u0 = acc[ai][1][m][0], u1 = acc[ai][1][m][1];
                u32x4 w;
                w.x = cvt_pk_bf16(silu_f(g0[0]) * u0[0], silu_f(g0[1]) * u0[1]); w.y = cvt_pk_bf16(silu_f(g0[2]) * u0[2], silu_f(g0[3]) * u0[3]);
                w.z = cvt_pk_bf16(silu_f(g1[0]) * u1[0], silu_f(g1[1]) * u1[1]); w.w = cvt_pk_bf16(silu_f(g1[2]) * u1[2], silu_f(g1[3]) * u1[3]);
                *(u32x4*)rowp = w; }
    }
};
struct EpiDown {
    static constexpr bool PERM = true, AFTER_DRAIN = false;
    bf16_t* Y;
    __device__ __forceinline__ void operator()(const f32x4 (&acc)[2][2][4][2], const Unit& u, int wr, int wc, int fr, int fq) const {
        const int row0 = u.pm * BM + wr * 64 + fr, col0 = (u.pn & 3) * BM + wc * 32 + 8 * fq;
#pragma unroll
        for (int ai = 0; ai < 2; ++ai)
#pragma unroll
            for (int m = 0; m < 4; ++m) { bf16_t* rowp = Y + (size_t)(row0 + ai * HALF + m * 16) * 1024 + col0;
#pragma unroll
                for (int bj = 0; bj < 2; ++bj) { const f32x4 v0 = acc[ai][bj][m][0], v1 = acc[ai][bj][m][1];
                    u32x4 w; w.x = cvt_pk_bf16(v0[0], v0[1]); w.y = cvt_pk_bf16(v0[2], v0[3]); w.z = cvt_pk_bf16(v1[0], v1[1]); w.w = cvt_pk_bf16(v1[2], v1[3]);
                    *(u32x4*)(rowp + bj * HALF) = w; } }
    }
};
struct MoeOrder {
    int tend, total, G, c, lane;
    __device__ __forceinline__ bool next(int i, Unit& u) const {
        const int L = i * G + c, mt = L >> 2; if (mt >= total) return false;
        const unsigned long long bal = __ballot(lane < 16 && mt >= tend);
        u.pm = mt; u.pn = (int)__popcll(bal) * 4 + (L & 3); return true;
    }
    __device__ __forceinline__ void a_ready(const Unit&) const {}
    __device__ __forceinline__ void done(const Unit&) const {}
};

template <class Epi, class Sched, bool ALIGN_EPI = false, bool SP2 = false>
__device__ __forceinline__ void gemm_phase(PG8_LAS unsigned char* lds, const Gemm g, const Sched& S, const Epi& E) {
    const int tid = threadIdx.x, wid = __builtin_amdgcn_readfirstlane(tid >> 6), lane = tid & 63, wr = wid >> 2, wc = wid & 3, fr = lane & 15, fq = lane >> 4;
    const int K = g.K, nt = K / BK;
    unsigned voffA[2], voffB[2];
#pragma unroll
    for (int i = 0; i < 2; ++i) { int R, C; stage_rc(tid * 16 + i * 8192, R, C); const int Rb = Epi::PERM ? ((R & ~31) + perm32(R & 31)) : R;
        voffA[i] = (unsigned)(R * K + C) * 2u; voffB[i] = (unsigned)(Rb * K + C) * 2u; }
    const size_t kstep = (size_t)(BK * 2);
    const size_t hstep = (size_t)HALF * K * 2;
    const size_t tstep = 2 * hstep;
    const unsigned ldsw = (unsigned)wid * 1024u;
    const int aoff = lds_byte(wr * 64 + fr, fq * 8), boff = lds_byte(wc * 32 + fr, fq * 8);
#define PG8_SA(b, h) (((b) * 2 + (h)) * HTB)
#define PG8_SB(b, h) ((4 + (b) * 2 + (h)) * HTB)
#define PG8_STAGE(bufoff, gbase, voff) do { _Pragma("unroll") for (int _i = 0; _i < 2; ++_i) \
        __builtin_amdgcn_global_load_lds((const unsigned*)((const char*)(gbase) + (voff)[_i]), (PG8_LAS unsigned*)(lds + (bufoff) + ldsw + _i * 8192), 16, 0, 0); } while (0)
#define PG8_LDA(dst, b, h) do { _Pragma("unroll") for (int m = 0; m < 4; ++m) _Pragma("unroll") for (int k = 0; k < 2; ++k) dst[m][k] = *(const PG8_LAS bf16x8*)(lds + PG8_SA(b, h) + aoff + m * 2048 + k * 1024); } while (0)
#define PG8_LDB(dst, b, h) do { _Pragma("unroll") for (int n = 0; n < 2; ++n) _Pragma("unroll") for (int k = 0; k < 2; ++k) dst[n][k] = *(const PG8_LAS bf16x8*)(lds + PG8_SB(b, h) + boff + n * 2048 + k * 1024); } while (0)
#define PG8_MMA(ai, bj, At, Bt) do { __builtin_amdgcn_s_setprio(1); _Pragma("unroll") for (int m = 0; m < 4; ++m) _Pragma("unroll") for (int n = 0; n < 2; ++n) _Pragma("unroll") for (int k = 0; k < 2; ++k) \
        acc[ai][bj][m][n] = __builtin_amdgcn_mfma_f32_16x16x32_bf16(Bt[n][k], At[m][k], acc[ai][bj][m][n], 0, 0, 0); __builtin_amdgcn_s_setprio(0); } while (0)
#define PG8_WAIT_V(n) asm volatile("s_waitcnt vmcnt(" #n ")" ::: "memory")
#define PG8_WAIT_L(n) asm volatile("s_waitcnt lgkmcnt(" #n ")" ::: "memory")
#define PG8_BAR __builtin_amdgcn_s_barrier()
#define PG8_SCHED __builtin_amdgcn_sched_barrier(0)
    Unit cur, nxt; int ui = 0;
    if (!S.next(0, cur)) return;
    f32x4 acc[2][2][4][2];
#pragma unroll
    for (int a = 0; a < 2; ++a)
#pragma unroll
        for (int b = 0; b < 2; ++b)
#pragma unroll
            for (int m = 0; m < 4; ++m)
#pragma unroll
                for (int n = 0; n < 2; ++n) acc[a][b][m][n] = (f32x4){0.f, 0.f, 0.f, 0.f};
    bf16x8 At[4][2], B0[2][2], B1[2][2];
    const char* cA = (const char*)g.A + (size_t)cur.pm * tstep; const char* cB = (const char*)g.Bt + (size_t)cur.pn * tstep;
    S.a_ready(cur);
    if constexpr (SP2) {
        PG8_STAGE(PG8_SB(0, 0), cB, voffB); PG8_STAGE(PG8_SB(0, 1), cB + hstep, voffB); PG8_STAGE(PG8_SA(0, 0), cA, voffA); PG8_STAGE(PG8_SA(0, 1), cA + hstep, voffA);
        if (wr == 1) PG8_BAR;
        PG8_WAIT_V(2); PG8_BAR;
        PG8_STAGE(PG8_SB(1, 0), cB + kstep, voffB); PG8_STAGE(PG8_SA(1, 0), cA + kstep, voffA); PG8_STAGE(PG8_SB(1, 1), cB + hstep + kstep, voffB);
        PG8_WAIT_V(6); PG8_BAR;
    } else {
        PG8_STAGE(PG8_SB(0, 0), cB, voffB); PG8_STAGE(PG8_SA(0, 0), cA, voffA); PG8_STAGE(PG8_SB(0, 1), cB + hstep, voffB); PG8_STAGE(PG8_SA(0, 1), cA + hstep, voffA);
        if (wr == 1) PG8_BAR;
        PG8_WAIT_V(4); PG8_BAR;
        PG8_STAGE(PG8_SB(1, 0), cB + kstep, voffB); PG8_STAGE(PG8_SA(1, 0), cA + kstep, voffA); PG8_STAGE(PG8_SB(1, 1), cB + hstep + kstep, voffB);
        PG8_WAIT_V(6); PG8_BAR;
    }
    for (;;) {
        const bool has_next = S.next(ui + 1, nxt);
        const char* nA = has_next ? (const char*)g.A + (size_t)nxt.pm * tstep : cA; const char* nB = has_next ? (const char*)g.Bt + (size_t)nxt.pn * tstep : cB;
        for (int t = 0; t < nt; t += 2) {
            const bool last = (t == nt - 2);
            const char* a1 = cA + (size_t)(t + 1) * kstep;
            const char* a2 = last ? nA : cA + (size_t)(t + 2) * kstep; const char* b2 = last ? nB : cB + (size_t)(t + 2) * kstep;
            const char* a3 = a2 + kstep; const char* b3 = b2 + kstep;
            if (last && has_next) S.a_ready(nxt);
            if constexpr (SP2) {
            PG8_LDB(B0, 0, 0); PG8_LDB(B1, 0, 1); PG8_SCHED; PG8_LDA(At, 0, 0); PG8_STAGE(PG8_SA(1, 1), a1 + hstep, voffA);
            PG8_WAIT_V(8); PG8_WAIT_L(0); PG8_BAR; PG8_MMA(0, 0, At, B0); PG8_MMA(0, 1, At, B1); PG8_BAR; PG8_SCHED;
            PG8_LDA(At, 0, 1); PG8_STAGE(PG8_SB(0, 0), b2, voffB); PG8_STAGE(PG8_SB(0, 1), b2 + hstep, voffB); PG8_STAGE(PG8_SA(0, 0), a2, voffA);
            PG8_WAIT_V(8); PG8_WAIT_L(0); PG8_BAR; PG8_MMA(1, 0, At, B0); PG8_MMA(1, 1, At, B1); PG8_BAR; PG8_SCHED;
            PG8_LDB(B0, 1, 0); PG8_LDB(B1, 1, 1); PG8_SCHED; PG8_LDA(At, 1, 0); PG8_STAGE(PG8_SA(0, 1), a2 + hstep, voffA);
            PG8_WAIT_V(8); PG8_WAIT_L(0); PG8_BAR; PG8_MMA(0, 0, At, B0); PG8_MMA(0, 1, At, B1); PG8_BAR; PG8_SCHED;
            PG8_LDA(At, 1, 1); PG8_STAGE(PG8_SB(1, 0), b3, voffB); PG8_STAGE(PG8_SB(1, 1), b3 + hstep, voffB); PG8_STAGE(PG8_SA(1, 0), a3, voffA);
            PG8_WAIT_V(8); PG8_WAIT_L(0); PG8_BAR; PG8_MMA(1, 0, At, B0); PG8_MMA(1, 1, At, B1); PG8_BAR; PG8_SCHED;
            } else {
            PG8_LDB(B0, 0, 0); PG8_SCHED; PG8_LDA(At, 0, 0); PG8_STAGE(PG8_SA(1, 1), a1 + hstep, voffA);
            PG8_WAIT_L(8); PG8_BAR; PG8_WAIT_L(0); PG8_MMA(0, 0, At, B0); PG8_BAR; PG8_SCHED;
            PG8_LDB(B1, 0, 1); PG8_STAGE(PG8_SB(0, 0), b2, voffB);
            PG8_BAR; PG8_WAIT_L(0); PG8_MMA(0, 1, At, B1); PG8_BAR;
            PG8_LDA(At, 0, 1); PG8_STAGE(PG8_SA(0, 0), a2, voffA);
            PG8_BAR; PG8_WAIT_L(0); PG8_MMA(1, 0, At, B0); PG8_BAR; PG8_SCHED;
            PG8_STAGE(PG8_SB(0, 1), b2 + hstep, voffB);
            PG8_WAIT_V(6); PG8_BAR; PG8_MMA(1, 1, At, B1); PG8_BAR;
            PG8_LDB(B0, 1, 0); PG8_SCHED; PG8_LDA(At, 1, 0); PG8_STAGE(PG8_SA(0, 1), a2 + hstep, voffA);
            PG8_WAIT_L(8); PG8_BAR; PG8_WAIT_L(0); PG8_MMA(0, 0, At, B0); PG8_BAR; PG8_SCHED;
            PG8_LDB(B1, 1, 1); PG8_STAGE(PG8_SB(1, 0), b3, voffB);
            PG8_BAR; PG8_WAIT_L(0); PG8_MMA(0, 1, At, B1); PG8_BAR;
            PG8_LDA(At, 1, 1); PG8_STAGE(PG8_SA(1, 0), a3, voffA);
            PG8_BAR; PG8_WAIT_L(0); PG8_MMA(1, 0, At, B0); PG8_BAR; PG8_SCHED;
            PG8_STAGE(PG8_SB(1, 1), b3 + hstep, voffB);
            PG8_WAIT_V(6); PG8_BAR; PG8_MMA(1, 1, At, B1); PG8_BAR;
            }
        }
        if constexpr (ALIGN_EPI) { if (wr == 0) PG8_BAR; }
        if constexpr (!Epi::AFTER_DRAIN) { E(acc, cur, wr, wc, fr, fq); S.done(cur); }
        if (!has_next) break;
#pragma unroll
        for (int a = 0; a < 2; ++a)
#pragma unroll
            for (int b = 0; b < 2; ++b)
#pragma unroll
                for (int m = 0; m < 4; ++m)
#pragma unroll
                    for (int n = 0; n < 2; ++n) acc[a][b][m][n] = (f32x4){0.f, 0.f, 0.f, 0.f};
        cur = nxt; cA = nA; cB = nB; ++ui;
        if constexpr (ALIGN_EPI) { if (wr == 1) PG8_BAR; }
    }
    PG8_WAIT_V(0);
    if constexpr (!ALIGN_EPI) { if (wr == 0) PG8_BAR; }
    PG8_BAR;
    if constexpr (Epi::AFTER_DRAIN) { E.fused(acc, cur, wr, wc, fr, fq, lds, wid, lane); S.done(cur); }
#undef PG8_SA
#undef PG8_SB
#undef PG8_STAGE
#undef PG8_LDA
#undef PG8_LDB
#undef PG8_MMA
#undef PG8_WAIT_V
#undef PG8_WAIT_L
#undef PG8_BAR
#undef PG8_SCHED
}
}

#ifndef PG8_SP2
#define PG8_SP2 true
#endif
#ifndef PG8_ALIGN
#define PG8_ALIGN true
#endif
#ifndef MK_N_LAUNCHES
#define MK_N_LAUNCHES 1
#endif

constexpr int NWAVES = 8;
constexpr int NB = 4, S = 4096, D = 1024, M = NB * S;
constexpr int NH = 8, SBW = 512, PJ = 2048, NE = 16, EH = 512;
constexpr float ALPHA = 1.189207115002721f;
constexpr float LN_EPS = 1e-5f;
constexpr float QSCALE = 0.125f * 1.4426950408889634f;
constexpr int N_PHASES = 10;
constexpr int N_LAUNCHES = MK_N_LAUNCHES;
constexpr int SORT_ROWS = 2 * M + NE * 256;

constexpr size_t MiB = 1u << 20;
constexpr size_t WS_CTL = 0, CTL_ZERO_BYTES = 1 * MiB;
constexpr size_t WS_MODP = 1 * MiB;
constexpr size_t WS_MOD = 2 * MiB;
constexpr size_t WS_ROUTE = 4 * MiB;
constexpr size_t WS_WIN = 8 * MiB;
constexpr size_t WS_WOUT = 12 * MiB;
constexpr size_t WS_WGU = 16 * MiB;
constexpr size_t WS_WD = 48 * MiB;
constexpr size_t WS_XN = 64 * MiB;
constexpr size_t WS_Q = 96 * MiB;
constexpr size_t WS_AO = 160 * MiB;
constexpr size_t WS_MIX = 96 * MiB;
constexpr size_t WS_XS = 96 * MiB;
constexpr size_t WS_HS = 168 * MiB;
constexpr size_t WS_END = 204 * MiB;
static_assert(WS_XS + (size_t)SORT_ROWS * 1024 * 2 <= WS_HS && WS_HS + (size_t)SORT_ROWS * 512 * 2 <= WS_END, "d_ws map");
constexpr int CW_TMO = 0, CW_CODE = 1, CW_BAR = 4096, CW_CNT = 16384;

constexpr int RING_OFF = 0, RING_BYTES = 131072;
constexpr int LDS_BYTES = 163840;
constexpr int LDSCTL_OFF = LDS_BYTES - 1024, MISC_OFF = LDSCTL_OFF + 320;
constexpr int WSCR = 16896, SIL_OFF = 139264;

#define GAS __attribute__((address_space(1)))
#define LAS __attribute__((address_space(3)))
typedef unsigned short bf16;
typedef unsigned v4u __attribute__((ext_vector_type(4)));
typedef unsigned v2u __attribute__((ext_vector_type(2)));
typedef float f32x4 __attribute__((ext_vector_type(4)));
typedef float f32x16 __attribute__((ext_vector_type(16)));
typedef short bf16x8 __attribute__((ext_vector_type(8)));
typedef short s16x4 __attribute__((ext_vector_type(4)));
typedef GAS unsigned gu32;
#define RLX_AGENT __ATOMIC_RELAXED, __HIP_MEMORY_SCOPE_AGENT
#define LDS_WAIT() asm volatile("s_waitcnt lgkmcnt(0)" ::: "memory")
#define VM_WAIT() asm volatile("s_waitcnt vmcnt(0)" ::: "memory")
__device__ __forceinline__ unsigned f2bf(float f) { unsigned u = __builtin_bit_cast(unsigned, f); return (u + 0x7fffu + ((u >> 16) & 1u)) >> 16; }
typedef float f32x2_t __attribute__((ext_vector_type(2))); typedef __bf16 bf16x2_t __attribute__((ext_vector_type(2)));
__device__ __forceinline__ unsigned pk2(float lo, float hi) { const f32x2_t v = {lo, hi}; return __builtin_bit_cast(unsigned, __builtin_convertvector(v, bf16x2_t)); }
__device__ __forceinline__ float bf_lo(unsigned w) { return __builtin_bit_cast(float, w << 16); }
__device__ __forceinline__ float bf_hi(unsigned w) { return __builtin_bit_cast(float, w & 0xffff0000u); }

#define XB_TMO      128
#define XB_XCNT(j)  (256  + 64 * (j))
#define XB_XSUB(j)  (1280 + 64 * (j))
#define XB_XGEN(j)  (2304 + 64 * (j))
#define XB_TOP      3328
#define XB_TOPGEN   3392
#define XCD_BAR_WORDS 3456
#define XB_SPIN_CAP (1u << 18)

__device__ __forceinline__ unsigned xb_ld(unsigned* p)              { return __hip_atomic_load(p, __ATOMIC_RELAXED, __HIP_MEMORY_SCOPE_AGENT); }
__device__ __forceinline__ unsigned xb_add(unsigned* p, unsigned v) { return __hip_atomic_fetch_add(p, v, __ATOMIC_RELAXED, __HIP_MEMORY_SCOPE_AGENT); }
__device__ __forceinline__ unsigned xb_xcc_id() { return (unsigned)__builtin_amdgcn_s_getreg((3 << 11) | 20) & 0xFu; }
#define XB_SPIN(cond, bar) do { unsigned _sp = 0; while (cond) { __builtin_amdgcn_s_sleep(1); \
    if ((++_sp & 255u) == 0u) { if (xb_ld(&(bar)[XB_TMO])) break; if (_sp > XB_SPIN_CAP) { atomicAdd(&(bar)[XB_TMO], 1u); break; } } } } while (0)

struct XcdBarrier {
    unsigned* bar; unsigned x;
    volatile LAS unsigned* st;
};

__device__ __forceinline__ XcdBarrier xcd_barrier_post(unsigned* bar, volatile LAS unsigned* st) {
    XcdBarrier b; b.bar = bar; b.x = xb_xcc_id(); b.st = st;
    if (threadIdx.x == 0) (void)xb_add(&bar[XB_XCNT(b.x)], 1u);
    return b;
}
__device__ __forceinline__ void xcd_barrier_complete(unsigned* bar, unsigned x, unsigned& nloc, unsigned& nx) {
    const unsigned G = gridDim.x * gridDim.y * gridDim.z;
    unsigned sum, cnt, mine, sp = 0u;
    for (;;) {
        sum = 0u; cnt = 0u; mine = 0u;
#pragma unroll
        for (unsigned j = 0; j < 16; ++j) { const unsigned c = xb_ld(&bar[XB_XCNT(j)]); sum += c; cnt += (c > 0u) ? 1u : 0u; mine = (j == x) ? c : mine; }
        if (sum == G) break;
        __builtin_amdgcn_s_sleep(1);
        if ((++sp & 255u) == 0u) { if (xb_ld(&bar[XB_TMO])) break; if (sp > XB_SPIN_CAP) { atomicAdd(&bar[XB_TMO], 1u); break; } }
    }
    nloc = mine > 0u ? mine : 1u; nx = cnt > 0u ? cnt : 1u;
}

__device__ __forceinline__ void xcd_barrier(const XcdBarrier& b) {
    asm volatile("s_waitcnt vmcnt(0)" ::: "memory");
    __syncthreads();
    if (threadIdx.x == 0) {
        unsigned* bar = b.bar;
        __builtin_amdgcn_s_waitcnt(0);
        unsigned nloc = b.st[0], nx = b.st[1];
        if (nloc == 0u) { xcd_barrier_complete(bar, b.x, nloc, nx); b.st[0] = nloc; b.st[1] = nx; }
        const unsigned old = xb_add(&bar[XB_XSUB(b.x)], 1u);
        const unsigned gen = old / nloc;
        if (old + 1u == (gen + 1u) * nloc) {
            __builtin_amdgcn_fence(__ATOMIC_RELEASE, "agent");
            asm volatile("s_waitcnt vmcnt(0)" ::: "memory");
            const unsigned og = xb_add(&bar[XB_TOP], 1u);
            const unsigned tg = og / nx;
            if (og + 1u == (tg + 1u) * nx) xb_add(&bar[XB_TOPGEN], 1u);
            else XB_SPIN(xb_ld(&bar[XB_TOPGEN]) == tg, bar);
            __builtin_amdgcn_fence(__ATOMIC_ACQUIRE, "agent");
            xb_add(&bar[XB_XGEN(b.x)], 1u);
            asm volatile("s_waitcnt vmcnt(0)" ::: "memory");
        } else {
            XB_SPIN(xb_ld(&bar[XB_XGEN(b.x)]) == gen, bar);
            __builtin_amdgcn_fence(__ATOMIC_ACQUIRE, "agent");
            asm volatile("s_waitcnt vmcnt(0)" ::: "memory");
        }
    }
    __syncthreads();
}

struct Args { const float* in[19]; float* out; unsigned char* ws; int ph_lo, ph_hi, li, pad; };
struct Frame {
    LAS unsigned char* lds;
    volatile LAS unsigned* MISC;
    gu32* ctl;
    int tid, lane, wave, vcu, G;
    float* out; unsigned char* ws;
    unsigned long long ta, tb;
};
#ifndef PROBE_STAMP
#define PROBE_STAMP -1
#endif
#define SUBSTAMP(F, k) do { if (PROBE_STAMP >= 0 && blockIdx.x == 0 && (F).tid == 0) { const unsigned long long t_ = __builtin_amdgcn_s_memrealtime(); if ((k) == PROBE_STAMP) (F).ta = t_; if ((k) == PROBE_STAMP + 1) (F).tb = t_; } } while (0)
template <int CTRL> __device__ __forceinline__ float dpp_ror(float v) { return __builtin_bit_cast(float, __builtin_amdgcn_update_dpp(0, __builtin_bit_cast(int, v), CTRL, 0xf, 0xf, false)); }
__device__ __forceinline__ float wave_sum(float v) {
    v += dpp_ror<0x128>(v); v += dpp_ror<0x124>(v); v += dpp_ror<0x122>(v); v += dpp_ror<0x121>(v);
    const int x = __builtin_bit_cast(int, v);
    const float a = __builtin_bit_cast(float, __builtin_amdgcn_readlane(x, 0)), b = __builtin_bit_cast(float, __builtin_amdgcn_readlane(x, 16));
    const float c = __builtin_bit_cast(float, __builtin_amdgcn_readlane(x, 32)), d = __builtin_bit_cast(float, __builtin_amdgcn_readlane(x, 48));
    return (a + b) + (c + d);
}

__device__ __forceinline__ float row16_sum(float v) { v += dpp_ror<0x128>(v); v += dpp_ror<0x124>(v); v += dpp_ror<0x122>(v); v += dpp_ror<0x121>(v); return v; }

__device__ __forceinline__ void transpose_item(const float* W, int ldw, int k0, int n0, bf16* WT, size_t drow, int ldd, int dk0, LAS float* scr, int lane) {
    f32x4 v[16];
    const float* Wp = W + (size_t)(k0 + (lane >> 4)) * ldw + n0 + (lane & 15) * 4;
#pragma unroll
    for (int i = 0; i < 16; ++i) v[i] = *(const f32x4*)(Wp + (size_t)(4 * i) * ldw);
    LAS float* wb = scr + (lane >> 4) * 65 + (lane & 15) * 4;
#pragma unroll
    for (int i = 0; i < 16; ++i)
#pragma unroll
        for (int c = 0; c < 4; ++c) wb[i * 260 + c] = v[i][c];
    LDS_WAIT(); asm volatile("" ::: "memory");
    const int c8 = lane & 7;
    const LAS float* rb = scr + (8 * c8) * 65 + (lane >> 3);
    bf16* Wo = WT + (drow + (lane >> 3)) * ldd + dk0 + 8 * c8;
#pragma unroll
    for (int j = 0; j < 8; ++j) { float s[8];
#pragma unroll
        for (int t = 0; t < 8; ++t) s[t] = rb[t * 65 + 8 * j];
        v4u o; o.x = pk2(s[0], s[1]); o.y = pk2(s[2], s[3]); o.z = pk2(s[4], s[5]); o.w = pk2(s[6], s[7]);
        *(GAS v4u*)(Wo + (size_t)(8 * j) * ldd) = o; }
    LDS_WAIT(); asm volatile("" ::: "memory");
}
constexpr int I_ADA = 768, I_EFF = 1024, I_WIN = 512, I_WOUT = 128, I_EXP = 2048;
constexpr int P0_ITEMS = I_ADA + I_EFF + I_WIN + I_WOUT;
__device__ __forceinline__ void p0_prologue(Frame& F, const Args& A) {
    const float* c = A.in[1]; const float* w_ada = A.in[2]; const float* w_in = A.in[4]; const float* w_pool = A.in[5]; const float* pool_scale = A.in[6];
    const float* w_out = A.in[7];
    bf16* Win_t = (bf16*)(F.ws + WS_WIN); bf16* Wout_t = (bf16*)(F.ws + WS_WOUT);
    float* modp = (float*)(F.ws + WS_MODP);
    LAS float* scr = (LAS float*)(F.lds + F.wave * WSCR);
    LAS f32x4* sil = (LAS f32x4*)(F.lds + SIL_OFF);
    for (int k = F.tid; k < D; k += NWAVES * 64) { f32x4 v;
#pragma unroll
        for (int b = 0; b < 4; ++b) { const float cv = c[b * D + k]; v[b] = cv / (1.f + __expf(-cv)); }
        sil[k] = v; }
    __syncthreads();
    const int gw = F.vcu * NWAVES + F.wave, NGW = F.G * NWAVES, lane = F.lane;
    int sn_ = 60; SUBSTAMP(F, sn_); ++sn_;
    for (int it = gw; it < P0_ITEMS; it += NGW, ({ SUBSTAMP(F, sn_); ++sn_; })) {
        int r = it;
        if (r < I_ADA) {
            const int kc = r / 96, ng = r % 96, n = ng * 64 + lane; f32x4 acc = {0.f, 0.f, 0.f, 0.f};
            const float* wp = w_ada + (size_t)(kc * 128) * 6144 + n;
            for (int h = 0; h < 4; ++h) { float wv[32];
#pragma unroll
                for (int k = 0; k < 32; ++k) wv[k] = __builtin_nontemporal_load(wp + (size_t)(h * 32 + k) * 6144);
#pragma unroll
                for (int k = 0; k < 32; ++k) acc += sil[kc * 128 + h * 32 + k] * wv[k]; }
#pragma unroll
            for (int b = 0; b < 4; ++b) modp[(size_t)(kc * 4 + b) * 6144 + n] = acc[b];
            continue; } r -= I_ADA;
        if (r < I_EFF) {
            const int g = r >> 8, nb = (r >> 4) & 15, c0 = (r & 15) * 8, n = nb * 64 + lane; float acc[8];
#pragma unroll
            for (int cc = 0; cc < 8; ++cc) acc[cc] = 0.f;
            const float* wo_p = w_out + (size_t)(512 + g * 128) * 1024 + n;
#pragma unroll
            for (int cc = 0; cc < 8; ++cc)
#pragma unroll
                for (int hh = 0; hh < 2; ++hh) { const int e = hh * 64 + lane; scr[e * 8 + cc] = w_pool[(size_t)(g * 128 + c0 + cc) * 128 + e] * pool_scale[g * 128 + e]; }
            LDS_WAIT(); asm volatile("" ::: "memory");
            for (int h = 0; h < 8; ++h) { float wo[16];
#pragma unroll
                for (int e = 0; e < 16; ++e) wo[e] = wo_p[(size_t)(h * 16 + e) * 1024];
#pragma unroll
                for (int e = 0; e < 16; ++e) { const f32x4 wa = *(const LAS f32x4*)(scr + (h * 16 + e) * 8), wb = *(const LAS f32x4*)(scr + (h * 16 + e) * 8 + 4);
                    acc[0] += wa.x * wo[e]; acc[1] += wa.y * wo[e]; acc[2] += wa.z * wo[e]; acc[3] += wa.w * wo[e];
                    acc[4] += wb.x * wo[e]; acc[5] += wb.y * wo[e]; acc[6] += wb.z * wo[e]; acc[7] += wb.w * wo[e]; } }
            LDS_WAIT(); asm volatile("" ::: "memory");
            v4u o; o.x = pk2(acc[0], acc[1]); o.y = pk2(acc[2], acc[3]); o.z = pk2(acc[4], acc[5]); o.w = pk2(acc[6], acc[7]);
            *(GAS v4u*)(Wout_t + (size_t)n * 1024 + 512 + g * 128 + c0) = o;
            continue; } r -= I_EFF;
        if (r < I_WIN) { const int kb = r >> 5, nb = r & 31; transpose_item(w_in, PJ, kb * 64, nb * 64, Win_t, (size_t)nb * 64, 1024, kb * 64, scr, lane); continue; } r -= I_WIN;
        { const int kb = r >> 4, nb = r & 15; transpose_item(w_out, 1024, kb * 64, nb * 64, Wout_t, (size_t)nb * 64, 1024, kb * 64, scr, lane); }
    }
}
__device__ __forceinline__ void expert_item(Frame& F, const Args& A, int r, LAS float* scr) {
    const float* w_gate = A.in[14]; const float* w_up = A.in[15]; const float* w_down = A.in[16];
    bf16* Wgu_t = (bf16*)(F.ws + WS_WGU); bf16* Wd_t = (bf16*)(F.ws + WS_WD);
    if (r < 2 * I_EXP) { const int up = r >= I_EXP; if (up) r -= I_EXP; const int e = r >> 7, kb = (r >> 3) & 15, nb = r & 7, n0 = nb * 64;
        const float* W = (up ? w_up : w_gate) + (size_t)e * D * EH;
        transpose_item(W, EH, kb * 64, n0, Wgu_t, (size_t)e * 1024 + (n0 >> 7) * 256 + up * 128 + (n0 & 127), 1024, kb * 64, scr, F.lane); return; }
    r -= 2 * I_EXP;
    { const int e = r >> 7, kb = (r >> 4) & 7, nb = r & 15;
        transpose_item(w_down + (size_t)e * EH * D, D, kb * 64, nb * 64, Wd_t, (size_t)e * 1024 + nb * 64, 512, kb * 64, scr, F.lane); }
}

__device__ __forceinline__ void p1_lnmod(Frame& F, const Args& A) {
    const float* x = A.in[0]; const float* b_ada = A.in[3]; const float* modp = (const float*)(F.ws + WS_MODP); float* mod = (float*)(F.ws + WS_MOD);
    bf16* XN = (bf16*)(F.ws + WS_XN);
    LAS float* sc = (LAS float*)F.lds; LAS float* sh = sc + 1024;
    for (int vb = F.vcu; vb < 256; vb += F.G) {
        const int b = vb >> 6;
        __syncthreads();
        for (int col = F.tid; col < 1024; col += NWAVES * 64) { float a = b_ada[col], s = b_ada[1024 + col];
#pragma unroll
            for (int kc = 0; kc < 8; ++kc) { a += modp[(size_t)(kc * 4 + b) * 6144 + col]; s += modp[(size_t)(kc * 4 + b) * 6144 + 1024 + col]; }
            sh[col] = a; sc[col] = 1.f + s; }
        if (F.tid < 96) { const int n = vb * 96 + F.tid, bb = n / 6144, nn = n % 6144; float a = b_ada[nn];
#pragma unroll
            for (int kc = 0; kc < 8; ++kc) a += modp[(size_t)(kc * 4 + bb) * 6144 + nn];
            mod[n] = a; }
        __syncthreads();
        f32x4 nx[4];
        { const GAS f32x4* x0 = (const GAS f32x4*)(x + (size_t)(vb * 64 + F.wave * 8) * D) + F.lane;
#pragma unroll
          for (int j = 0; j < 4; ++j) nx[j] = x0[64 * j]; }
        for (int i = 0; i < 8; ++i) {
            const int m = vb * 64 + F.wave * 8 + i;
            f32x4 v[4]; float s = 0.f;
#pragma unroll
            for (int j = 0; j < 4; ++j) { v[j] = nx[j]; s += (v[j].x + v[j].y) + (v[j].z + v[j].w); }
            if (i < 7) { const GAS f32x4* xn = (const GAS f32x4*)(x + (size_t)(m + 1) * D) + F.lane;
#pragma unroll
                for (int j = 0; j < 4; ++j) nx[j] = xn[64 * j]; }
            const float mean = wave_sum(s) * (1.f / D); float s2 = 0.f;
#pragma unroll
            for (int j = 0; j < 4; ++j) { v[j] = v[j] - mean; s2 += (v[j].x * v[j].x + v[j].y * v[j].y) + (v[j].z * v[j].z + v[j].w * v[j].w); }
            const float rstd = 1.f / sqrtf(wave_sum(s2) * (1.f / D) + LN_EPS);
            GAS v2u* o8 = (GAS v2u*)(XN + (size_t)m * D) + F.lane;
#pragma unroll
            for (int j = 0; j < 4; ++j) { const f32x4 a = *(const LAS f32x4*)(sc + 256 * j + 4 * F.lane), bsh = *(const LAS f32x4*)(sh + 256 * j + 4 * F.lane);
                const f32x4 o = v[j] * rstd * a + bsh; v2u w; w.x = pk2(o.x, o.y); w.y = pk2(o.z, o.w); o8[64 * j] = w; }
        }
    }
}

__device__ __forceinline__ int crow(int r, int hi) { return (r & 3) + 8 * (r >> 2) + 4 * hi; }
__device__ __forceinline__ s16x4 vtr(const LAS unsigned char* p) { return __builtin_bit_cast(s16x4, __builtin_amdgcn_ds_read_tr16_b64_v4i16((LAS s16x4*)p)); }
#ifndef ATT_EARLY_EXIT
#define ATT_EARLY_EXIT 1
#endif
template <bool DIAG> __device__ __forceinline__ void sb_group(float& z0, float& z1, float& z2, float& z3, float& R, int hi, int key0, int qabs) {
    float be[4], w[4]; const float z[4] = {z0, z1, z2, z3};
#pragma unroll
    for (int i = 0; i < 4; ++i) { const float t = __builtin_amdgcn_exp2f(-__builtin_fabsf(z[i])), rr = __builtin_amdgcn_rcpf(1.f + t), tr = t * rr; const bool pos = z[i] >= 0.f;
        be[i] = pos ? rr : tr; w[i] = pos ? tr : rr;
        if (DIAG) { if (key0 + i >= qabs) { be[i] = 0.f; w[i] = 1.f; } } }
    const float G = ((w[3] * w[2]) * w[1]) * w[0];
    auto sw = __builtin_amdgcn_permlane32_swap(__float_as_uint(G), __float_as_uint(G), false, false);
    const float Glo = __uint_as_float(sw[0]), Ghi = __uint_as_float(sw[1]);
    const float off = hi ? R : R * Ghi;
    const float o2 = off * w[3], o1 = o2 * w[2], o0 = o1 * w[1];
    z3 = be[3] * off; z2 = be[2] * o2; z1 = be[1] * o1; z0 = be[0] * o0;
    R = R * (Glo * Ghi);
}
template <bool DIAG> __device__ __forceinline__ void sb_tile(f32x16& p0, f32x16& p1, float& R, int hi, int kb, int qabs) {
#pragma unroll
    for (int g = 3; g >= 0; --g) { float a = p1[4 * g], b = p1[4 * g + 1], c = p1[4 * g + 2], d = p1[4 * g + 3];
        sb_group<DIAG>(a, b, c, d, R, hi, kb + 32 + 8 * g + 4 * hi, qabs); p1[4 * g] = a; p1[4 * g + 1] = b; p1[4 * g + 2] = c; p1[4 * g + 3] = d; }
#pragma unroll
    for (int g = 3; g >= 0; --g) { float a = p0[4 * g], b = p0[4 * g + 1], c = p0[4 * g + 2], d = p0[4 * g + 3];
        sb_group<DIAG>(a, b, c, d, R, hi, kb + 8 * g + 4 * hi, qabs); p0[4 * g] = a; p0[4 * g + 1] = b; p0[4 * g + 2] = c; p0[4 * g + 3] = d; }
}
__device__ __forceinline__ void attn_unit(int b, int h, int qb, const bf16* Q, const bf16* K, const bf16* V, bf16* AO, LAS unsigned char* wl  , int lane) {
    const int r32 = lane & 31, hi = lane >> 5, q0 = qb * 32, qabs = q0 + r32; const size_t rowbase = (size_t)b * S;
    const int jmax = q0 >> 6;
    const int srow = lane >> 3, sch = lane & 7;
    const unsigned voff = (unsigned)(srow * SBW + sch * 8);
    const bf16* Kt = K + (rowbase + (size_t)jmax * 64) * SBW + h * 64;
    const bf16* Vt = V + (rowbase + (size_t)jmax * 64) * SBW + h * 64;
    v4u kk[8], vv[8];
#pragma unroll
    for (int i = 0; i < 8; ++i) { kk[i] = *(const v4u*)(Kt + i * 8 * SBW + voff); vv[i] = *(const v4u*)(Vt + i * 8 * SBW + voff); }
    const bf16* Qw = Q + (rowbase + q0 + r32) * SBW + h * 64 + hi * 8;
    bf16x8 qr[4];
#pragma unroll
    for (int d0 = 0; d0 < 4; ++d0) qr[d0] = *(const bf16x8*)(Qw + d0 * 16);
    f32x16 o0, o1;
#pragma unroll
    for (int r = 0; r < 16; ++r) { o0[r] = 0.f; o1[r] = 0.f; }
    float R = 1.f;
    LAS unsigned char* kl = wl; LAS unsigned char* vl = wl + 8192;
    const LAS unsigned char* vp = vl + ((lane >> 4) & 1) * 32 + (lane & 3) * 8 + (4 * hi + ((lane & 15) >> 2)) * 64;
    LAS unsigned char* kwb = kl + sch * 1024 + ((srow ^ sch) * 16); LAS unsigned char* vwb = vl + (sch >> 2) * 4096 + srow * 64 + (sch & 3) * 16;
    for (int j = jmax; j >= 0; --j) {
#pragma unroll
        for (int i = 0; i < 8; ++i) {
            *(LAS v4u*)(kwb + i * 128) = kk[i];
            *(LAS v4u*)(vwb + (i >> 1) * 1024 + (i & 1) * 512) = vv[i]; }
        if (j > 0) {
            Kt -= (size_t)64 * SBW; Vt -= (size_t)64 * SBW;
#pragma unroll
            for (int i = 0; i < 8; ++i) { kk[i] = *(const v4u*)(Kt + i * 8 * SBW + voff); vv[i] = *(const v4u*)(Vt + i * 8 * SBW + voff); }
        }
        f32x16 p0, p1;
#pragma unroll
        for (int r = 0; r < 16; ++r) { p0[r] = 0.f; p1[r] = 0.f; }
#pragma unroll
        for (int d0 = 0; d0 < 4; ++d0) { const int c = 2 * d0 + hi;
            const bf16x8 k0 = *(const LAS bf16x8*)(kl + c * 1024 + ((r32 ^ c) * 16)), k1 = *(const LAS bf16x8*)(kl + c * 1024 + 512 + ((r32 ^ c) * 16));
            p0 = __builtin_amdgcn_mfma_f32_32x32x16_bf16(k0, qr[d0], p0, 0, 0, 0); p1 = __builtin_amdgcn_mfma_f32_32x32x16_bf16(k1, qr[d0], p1, 0, 0, 0); }
        sb_tile<true>(p0, p1, R, hi, 64 * j, (j == jmax) ? qabs : 0x7fffffff);
        bf16x8 pa[4];
        { v4u w;
          w.x = pk2(p0[0], p0[1]); w.y = pk2(p0[2], p0[3]); w.z = pk2(p0[4], p0[5]); w.w = pk2(p0[6], p0[7]); pa[0] = __builtin_bit_cast(bf16x8, w);
          w.x = pk2(p0[8], p0[9]); w.y = pk2(p0[10], p0[11]); w.z = pk2(p0[12], p0[13]); w.w = pk2(p0[14], p0[15]); pa[1] = __builtin_bit_cast(bf16x8, w);
          w.x = pk2(p1[0], p1[1]); w.y = pk2(p1[2], p1[3]); w.z = pk2(p1[4], p1[5]); w.w = pk2(p1[6], p1[7]); pa[2] = __builtin_bit_cast(bf16x8, w);
          w.x = pk2(p1[8], p1[9]); w.y = pk2(p1[10], p1[11]); w.z = pk2(p1[12], p1[13]); w.w = pk2(p1[14], p1[15]); pa[3] = __builtin_bit_cast(bf16x8, w); }
#pragma unroll
        for (int ks = 0; ks < 4; ++ks) {
            const s16x4 l0 = vtr(vp + ks * 1024), h0 = vtr(vp + ks * 1024 + 512), l1 = vtr(vp + 4096 + ks * 1024), h1 = vtr(vp + 4096 + ks * 1024 + 512);
            const bf16x8 f0 = {l0[0], l0[1], l0[2], l0[3], h0[0], h0[1], h0[2], h0[3]}, f1 = {l1[0], l1[1], l1[2], l1[3], h1[0], h1[1], h1[2], h1[3]};
            o0 = __builtin_amdgcn_mfma_f32_32x32x16_bf16(pa[ks], f0, o0, 0, 0, 0);
            o1 = __builtin_amdgcn_mfma_f32_32x32x16_bf16(pa[ks], f1, o1, 0, 0, 0);
        }
#if ATT_EARLY_EXIT
        if (__all(R < 1.17549435e-38f)) break;
#endif
    }
    { LAS bf16* stg = (LAS bf16*)kl;
#pragma unroll
      for (int r = 0; r < 16; ++r) { const int q = crow(r, hi); stg[q * 64 + r32] = (bf16)f2bf(o0[r]); stg[q * 64 + 32 + r32] = (bf16)f2bf(o1[r]); }
      bf16* Ow = AO + (rowbase + q0) * D + h * 64;
#pragma unroll
      for (int i = 0; i < 4; ++i) { const int row = i * 8 + (lane >> 3), ch = lane & 7; const v4u v = *(const LAS v4u*)(stg + row * 64 + ch * 8); *(GAS v4u*)(Ow + (size_t)row * D + ch * 8) = v; } }
}
__device__ __forceinline__ void pool_item(int it, const bf16* P, bf16* AO, int lane) {
    const int m0 = it * 8, t0 = m0 & (S - 1), w = 2 << (lane >> 4);
    const bf16* Pc = P + lane * 8;
    v4u hal[15], cur[8];
#pragma unroll
    for (int k = 1; k <= 15; ++k) { hal[k - 1] = (v4u){0u, 0u, 0u, 0u}; if (k < w && t0 - k >= 0) hal[k - 1] = *(const v4u*)(Pc + (size_t)(m0 - k) * SBW); }
#pragma unroll
    for (int r = 0; r < 8; ++r) cur[r] = *(const v4u*)(Pc + (size_t)(m0 + r) * SBW);
#pragma unroll
    for (int r = 0; r < 8; ++r) {
        float s[8];
#pragma unroll
        for (int i = 0; i < 8; ++i) s[i] = 0.f;
#pragma unroll
        for (int k = 0; k <= 15; ++k) {
            const int rr = r - k;
            const v4u v = rr >= 0 ? cur[rr >= 0 ? rr : 0] : hal[rr >= 0 ? 0 : -rr - 1];
            if (k < w) { s[0] += bf_lo(v.x); s[1] += bf_hi(v.x); s[2] += bf_lo(v.y); s[3] += bf_hi(v.y); s[4] += bf_lo(v.z); s[5] += bf_hi(v.z); s[6] += bf_lo(v.w); s[7] += bf_hi(v.w); }
        }
        const int t = t0 + r; const float inv = 1.f / (float)((t + 1 < w) ? t + 1 : w);
        const v4u c = cur[r];
        v4u o; o.x = pk2(s[0] * inv - bf_lo(c.x), s[1] * inv - bf_hi(c.x)); o.y = pk2(s[2] * inv - bf_lo(c.y), s[3] * inv - bf_hi(c.y));
        o.z = pk2(s[4] * inv - bf_lo(c.z), s[5] * inv - bf_hi(c.z)); o.w = pk2(s[6] * inv - bf_lo(c.w), s[7] * inv - bf_hi(c.w));
        *(GAS v4u*)(AO + (size_t)(m0 + r) * D + 512 + lane * 8) = o;
    }
}
__device__ __forceinline__ void p3_attn_pool(Frame& F, const Args& A) {
    const bf16* Q = (const bf16*)(F.ws + WS_Q); const bf16* K = Q + (size_t)M * SBW; const bf16* V = K + (size_t)M * SBW; const bf16* P = V + (size_t)M * SBW;
    bf16* AO = (bf16*)(F.ws + WS_AO);
    const int gw = F.vcu * NWAVES + F.wave, NGW = F.G * NWAVES;
    LAS unsigned char* wl = F.lds + F.wave * WSCR;
    for (int it = gw; it < M / 8; it += NGW) pool_item(it, P, AO, F.lane);
    if (F.wave & 1) for (int it = gw; it < 3 * I_EXP; it += NGW) expert_item(F, A, it, (LAS float*)wl);
    for (int uid = gw; uid < NB * NH * (S / 32); uid += NGW) attn_unit(uid >> 10, (uid >> 7) & 7, uid & 127, Q, K, V, AO, wl, F.lane);
    if (!(F.wave & 1)) for (int it = gw; it < 3 * I_EXP; it += NGW) expert_item(F, A, it, (LAS float*)wl);
}

__device__ __forceinline__ void moe_tiles(Frame& F, int& tstart, int& tend, int& total) {
    const int n = F.lane < 16 ? (int)__hip_atomic_load(F.ctl + CW_CNT + 64 * F.lane, RLX_AGENT) : 0;
    const int tiles = (n + 255) >> 8; int incl = tiles;
#pragma unroll
    for (int o = 1; o < 16; o <<= 1) { const int v = __shfl_up(incl, o); if (F.lane >= o) incl += v; }
    tend = F.lane < 16 ? incl : 0x7fffffff; tstart = incl - tiles; total = __builtin_amdgcn_readlane(incl, 15);
}

__device__ __forceinline__ void route_row(const float (&pl)[20], int& ea, int& eb, float& w1, float& w2) {
    float gl[4], el[16];
#pragma unroll
    for (int t = 0; t < 4; ++t) gl[t] = pl[t];
#pragma unroll
    for (int t = 0; t < 16; ++t) el[t] = pl[4 + t];
    int gi = 0; float gm = gl[0];
#pragma unroll
    for (int t = 1; t < 4; ++t) if (gl[t] > gm) { gm = gl[t]; gi = t; }
    float den = 0.f;
#pragma unroll
    for (int t = 0; t < 4; ++t) den += __expf(gl[t] - gm);
    const float gp = 1.f / den;
    float es[4];
#pragma unroll
    for (int t = 0; t < 4; ++t) es[t] = gi == 0 ? el[t] : gi == 1 ? el[4 + t] : gi == 2 ? el[8 + t] : el[12 + t];
    int i1 = 0; float v1 = es[0];
#pragma unroll
    for (int t = 1; t < 4; ++t) if (es[t] > v1) { v1 = es[t]; i1 = t; }
    int i2 = 0; float v2 = -INFINITY;
#pragma unroll
    for (int t = 0; t < 4; ++t) if (t != i1 && es[t] > v2) { v2 = es[t]; i2 = t; }
    const float e2 = __expf(v2 - v1); w1 = gp / (1.f + e2); w2 = gp * e2 / (1.f + e2);
    ea = gi * 4 + i1; eb = gi * 4 + i2;
}
__device__ __forceinline__ void p5_post(Frame& F, const Args& A, const bool dry = false) {
    const float* x = A.in[0]; const float* ln1_g = A.in[8]; const float* ln1_b = A.in[9]; const float* w_rg = A.in[10]; const float* b_rg = A.in[11]; const float* w_re = A.in[12]; const float* b_re = A.in[13];
    const float* mod = (const float*)(F.ws + WS_MOD); const bf16* MIX = (const bf16*)(F.ws + WS_MIX);
    bf16* U2 = (bf16*)(F.ws + (dry ? WS_AO : WS_XN)); unsigned* route = (unsigned*)(F.ws + WS_ROUTE);
    float* x1o = dry ? (float*)(F.ws + WS_HS) : F.out;
    LAS f32x4* Wl = (LAS f32x4*)F.lds;
    LAS f32x4* Lg1 = (LAS f32x4*)(F.lds + 81920); LAS f32x4* Lb1 = Lg1 + 256; LAS f32x4* Ls2 = Lb1 + 256; LAS f32x4* Lh2 = Ls2 + 256;
    LAS int* asg = (LAS int*)(F.lds + 98304);
    LAS int* rnk = asg + 128; LAS int* lcnt = rnk + 128; LAS int* lbase = lcnt + 16; LAS float* wts = (LAS float*)(lbase + 16);
    SUBSTAMP(F, 50);
    LAS float* lgs = (LAS float*)(F.lds + 100352);
    for (int idx = F.tid; idx < 5 * 1024; idx += NWAVES * 64) { const int j5 = idx >> 10, col = idx & 1023;
        const f32x4 v = (j5 == 0) ? *(const f32x4*)(w_rg + col * 4) : *(const f32x4*)(w_re + col * 16 + (j5 - 1) * 4);
        Wl[j5 * 1024 + ((col >> 8) * 4 + (col & 3)) * 64 + ((col >> 2) & 63)] = v; }
    if (F.tid < 256) { Lg1[F.tid] = ((const f32x4*)ln1_g)[F.tid]; Lb1[F.tid] = ((const f32x4*)ln1_b)[F.tid]; }
    LAS float* Lbias = (LAS float*)(F.lds + 99840);
    if (F.tid < 20) Lbias[F.tid] = F.tid < 4 ? b_rg[F.tid] : b_re[F.tid - 4];
    for (int vb = F.vcu; vb < 256; vb += F.G) {
        const int b = vb >> 6;
        __syncthreads();
        if (F.tid < 256) { Ls2[F.tid] = ((const f32x4*)(mod + b * 6144 + 4096))[F.tid] + 1.0f; Lh2[F.tid] = ((const f32x4*)(mod + b * 6144 + 3072))[F.tid]; }
        if (F.tid < 16) lcnt[F.tid] = 0;
        __syncthreads();
        const int m0 = vb * 64 + F.wave * 8;
        SUBSTAMP(F, 51);
        f32x4 nx[4]; v2u nm[4];
#pragma unroll
        for (int j = 0; j < 4; ++j) { nx[j] = ((const GAS f32x4*)(x + (size_t)m0 * D))[64 * j + F.lane]; nm[j] = ((const GAS v2u*)(MIX + (size_t)m0 * D))[64 * j + F.lane]; }
        for (int i = 0; i < 8; ++i) {
            const int m = m0 + i;
            f32x4 v[4]; float s = 0.f;
#pragma unroll
            for (int j = 0; j < 4; ++j) { const v2u mm = nm[j]; const f32x4 mx = {bf_lo(mm.x), bf_hi(mm.x), bf_lo(mm.y), bf_hi(mm.y)};
                v[j] = nx[j] * ALPHA + mx; s += (v[j].x + v[j].y) + (v[j].z + v[j].w); }
            if (i < 7) {
#pragma unroll
                for (int j = 0; j < 4; ++j) { nx[j] = ((const GAS f32x4*)(x + (size_t)(m + 1) * D))[64 * j + F.lane]; nm[j] = ((const GAS v2u*)(MIX + (size_t)(m + 1) * D))[64 * j + F.lane]; } }
            float mean = wave_sum(s) * (1.f / D), q = 0.f;
#pragma unroll
            for (int j = 0; j < 4; ++j) { v[j] = v[j] - mean; q += (v[j].x * v[j].x + v[j].y * v[j].y) + (v[j].z * v[j].z + v[j].w * v[j].w); }
            float rstd = 1.f / sqrtf(wave_sum(q) * (1.f / D) + LN_EPS);
            s = 0.f;
            GAS f32x4* xw = (GAS f32x4*)(x1o + (size_t)m * D) + F.lane;
#pragma unroll
            for (int j = 0; j < 4; ++j) { v[j] = v[j] * rstd * Lg1[64 * j + F.lane] + Lb1[64 * j + F.lane]; xw[64 * j] = v[j]; s += (v[j].x + v[j].y) + (v[j].z + v[j].w); }
            mean = wave_sum(s) * (1.f / D); q = 0.f;
#pragma unroll
            for (int j = 0; j < 4; ++j) { v[j] = v[j] - mean; q += (v[j].x * v[j].x + v[j].y * v[j].y) + (v[j].z * v[j].z + v[j].w * v[j].w); }
            rstd = 1.f / sqrtf(wave_sum(q) * (1.f / D) + LN_EPS);
            float pl[20];
#pragma unroll
            for (int t = 0; t < 20; ++t) pl[t] = 0.f;
#pragma unroll
            for (int j = 0; j < 4; ++j) { v[j] = v[j] * rstd * Ls2[64 * j + F.lane] + Lh2[64 * j + F.lane]; v2u w; w.x = pk2(v[j].x, v[j].y); w.y = pk2(v[j].z, v[j].w);
                ((GAS v2u*)(U2 + (size_t)m * D))[64 * j + F.lane] = w;
                f32x4 wv[4][5];
#pragma unroll
                for (int i4 = 0; i4 < 4; ++i4)
#pragma unroll
                    for (int j5 = 0; j5 < 5; ++j5) wv[i4][j5] = Wl[j5 * 1024 + (j * 4 + i4) * 64 + F.lane];
#pragma unroll
                for (int i4 = 0; i4 < 4; ++i4) { const float uu = v[j][i4];
#pragma unroll
                    for (int j5 = 0; j5 < 5; ++j5) { pl[j5 * 4 + 0] += uu * wv[i4][j5].x; pl[j5 * 4 + 1] += uu * wv[i4][j5].y; pl[j5 * 4 + 2] += uu * wv[i4][j5].z; pl[j5 * 4 + 3] += uu * wv[i4][j5].w; } } }
            {
                LAS float* lg = lgs + (F.wave * 8 + i) * 20;
#pragma unroll
                for (int t = 0; t < 20; ++t) pl[t] = wave_sum(pl[t]);
                if (F.lane == 0) {
#pragma unroll
                    for (int t = 0; t < 20; ++t) lg[t] = pl[t]; }
            }
        }
        SUBSTAMP(F, 52);
        __syncthreads();
        if (F.tid < 64) {
            float pl[20];
#pragma unroll
            for (int t = 0; t < 20; ++t) pl[t] = lgs[F.tid * 20 + t] + Lbias[t];
            int ea, eb; float w1, w2; route_row(pl, ea, eb, w1, w2);
            asg[2 * F.tid] = ea; asg[2 * F.tid + 1] = eb; wts[2 * F.tid] = w1; wts[2 * F.tid + 1] = w2;
        }
        __syncthreads();
        if (F.tid < 128) rnk[F.tid] = atomicAdd((int*)&lcnt[asg[F.tid]], 1);
        __syncthreads();
        if (F.tid < 16) lbase[F.tid] = dry ? 0 : (int)__hip_atomic_fetch_add(F.ctl + CW_CNT + 64 * F.tid, (unsigned)lcnt[F.tid], RLX_AGENT);
        __syncthreads();
        if (F.tid < 128 && !dry) { const int m = vb * 64 + (F.tid >> 1), k = F.tid & 1, e = asg[F.tid];
            route[(size_t)m * 8 + 2 * k] = (unsigned)e; route[(size_t)m * 8 + 2 * k + 1] = (unsigned)(lbase[e] + rnk[F.tid]); route[(size_t)m * 8 + 4 + k] = __float_as_uint(wts[F.tid]); }
    }
    SUBSTAMP(F, 53);
}

__device__ __forceinline__ void p6_gather(Frame& F) {
    const bf16* U2 = (const bf16*)(F.ws + WS_XN); bf16* XS = (bf16*)(F.ws + WS_XS); const unsigned* route = (const unsigned*)(F.ws + WS_ROUTE);
    int tstart, tend, total; moe_tiles(F, tstart, tend, total);
    const int gw = F.vcu * NWAVES + F.wave, NGW = F.G * NWAVES;
    for (int m = gw; m < M; m += NGW) {
        const v4u rt = *(const v4u*)(route + (size_t)m * 8);
        const int r1 = __shfl(tstart, (int)rt.x) * 256 + (int)rt.y, r2 = __shfl(tstart, (int)rt.z) * 256 + (int)rt.w;
        const GAS v4u* src = (const GAS v4u*)(U2 + (size_t)m * D) + F.lane;
        const v4u a = src[0], c = src[64];
        GAS v4u* d1 = (GAS v4u*)(XS + (size_t)r1 * D) + F.lane; GAS v4u* d2 = (GAS v4u*)(XS + (size_t)r2 * D) + F.lane;
        d1[0] = a; d1[64] = c; d2[0] = a; d2[64] = c;
    }
}

__device__ __forceinline__ void p9_final(Frame& F, const Args& A, const bool dry = false) {
    const float* ln2_g = A.in[17]; const float* ln2_b = A.in[18]; const float* mod = (const float*)(F.ws + WS_MOD);
    const bf16* YS = (const bf16*)(F.ws + WS_XS); const unsigned* route = (const unsigned*)(F.ws + WS_ROUTE);
    int tstart, tend, total; moe_tiles(F, tstart, tend, total);
    const int gw = F.vcu * NWAVES + F.wave, NGW = F.G * NWAVES;
    f32x4 g2[4], b2[4];
#pragma unroll
    for (int j = 0; j < 4; ++j) { g2[j] = ((const f32x4*)ln2_g)[64 * j + F.lane]; b2[j] = ((const f32x4*)ln2_b)[64 * j + F.lane]; }
    for (int mb = gw * 8; mb < M; mb += NGW * 8) {
        f32x4 xv[4]; v2u ya[4], yc[4]; v2u wt;
        { const v4u rt = *(const v4u*)(route + (size_t)mb * 8); wt = *(const v2u*)(route + (size_t)mb * 8 + 4);
          const int r1 = __shfl(tstart, (int)rt.x) * 256 + (int)rt.y, r2 = __shfl(tstart, (int)rt.z) * 256 + (int)rt.w;
#pragma unroll
          for (int j = 0; j < 4; ++j) { xv[j] = ((const GAS f32x4*)(F.out + (size_t)mb * D))[64 * j + F.lane]; ya[j] = ((const GAS v2u*)(YS + (size_t)r1 * D))[64 * j + F.lane]; yc[j] = ((const GAS v2u*)(YS + (size_t)r2 * D))[64 * j + F.lane]; } }
        for (int i = 0; i < 8; ++i) {
            const int m = mb + i, b = m >> 12;
            const float w1 = __uint_as_float(wt.x), w2 = __uint_as_float(wt.y);
            f32x4 v[4]; float s = 0.f;
#pragma unroll
            for (int j = 0; j < 4; ++j) { const v2u a = ya[j], c = yc[j];
                const f32x4 gt = ((const f32x4*)(mod + b * 6144 + 5120))[64 * j + F.lane] + 1.0f;
                f32x4 y; y.x = w1 * bf_lo(a.x) + w2 * bf_lo(c.x); y.y = w1 * bf_hi(a.x) + w2 * bf_hi(c.x); y.z = w1 * bf_lo(a.y) + w2 * bf_lo(c.y); y.w = w1 * bf_hi(a.y) + w2 * bf_hi(c.y);
                v[j] = xv[j] * ALPHA + gt * y; s += (v[j].x + v[j].y) + (v[j].z + v[j].w); }
            if (i < 7) { const v4u rt = *(const v4u*)(route + (size_t)(m + 1) * 8); wt = *(const v2u*)(route + (size_t)(m + 1) * 8 + 4);
                const int r1 = __shfl(tstart, (int)rt.x) * 256 + (int)rt.y, r2 = __shfl(tstart, (int)rt.z) * 256 + (int)rt.w;
#pragma unroll
                for (int j = 0; j < 4; ++j) { xv[j] = ((const GAS f32x4*)(F.out + (size_t)(m + 1) * D))[64 * j + F.lane]; ya[j] = ((const GAS v2u*)(YS + (size_t)r1 * D))[64 * j + F.lane]; yc[j] = ((const GAS v2u*)(YS + (size_t)r2 * D))[64 * j + F.lane]; } }
            const float mean = wave_sum(s) * (1.f / D); float q = 0.f;
#pragma unroll
            for (int j = 0; j < 4; ++j) { v[j] = v[j] - mean; q += (v[j].x * v[j].x + v[j].y * v[j].y) + (v[j].z * v[j].z + v[j].w * v[j].w); }
            const float rstd = 1.f / sqrtf(wave_sum(q) * (1.f / D) + LN_EPS);
            GAS f32x4* ow = (GAS f32x4*)((dry ? (float*)(F.ws + WS_HS) : F.out) + (size_t)m * D) + F.lane;
#pragma unroll
            for (int j = 0; j < 4; ++j) ow[64 * j] = v[j] * rstd * g2[j] + b2[j];
        }
    }
}

__global__ void __launch_bounds__(NWAVES * 64, 2) mk_fwd(Args args) {
    extern __shared__ __attribute__((aligned(16))) unsigned char lds[];
    Frame F;
    F.lds = (LAS unsigned char*)lds;
    F.MISC = (volatile LAS unsigned*)(F.lds + MISC_OFF);
    F.tid = threadIdx.x; F.lane = F.tid & 63; F.wave = __builtin_amdgcn_readfirstlane(F.tid >> 6);
    F.G = gridDim.x; { const int bx = blockIdx.x; F.vcu = (F.G % 8 == 0) ? (bx % 8) * (F.G / 8) + bx / 8 : bx; }
    F.ws = args.ws; F.out = args.out; F.ctl = (gu32*)(args.ws + WS_CTL);
    for (int u = F.tid; u < (LDS_BYTES - LDSCTL_OFF) / 4; u += NWAVES * 64) ((LAS unsigned*)(F.lds + LDSCTL_OFF))[u] = 0u;
    __syncthreads();
    XcdBarrier bar; bar.bar = (unsigned*)(F.ctl + CW_BAR); bar.x = 0; bar.st = nullptr;
    if (N_LAUNCHES == 1) bar = xcd_barrier_post((unsigned*)(F.ctl + CW_BAR), F.MISC + 8);
#define GRID_BAR() do { if (N_LAUNCHES == 1) xcd_barrier(bar); } while (0)
#ifndef PROBE_STAMP
#define PROBE_STAMP -1
#endif
    F.ta = 0; F.tb = 0;
#define STAMP(k) do { if (PROBE_STAMP >= 0 && blockIdx.x == 0 && F.tid == 0) { const unsigned long long t_ = __builtin_amdgcn_s_memrealtime(); if ((k) == PROBE_STAMP) F.ta = t_; if ((k) == PROBE_STAMP + 1) F.tb = t_; } } while (0)
    STAMP(0);
    const int lo = args.ph_lo, hi = args.ph_hi;
#ifndef PROBE_DOUBLE
#define PROBE_DOUBLE -1
#endif
#define REP(k) for (int rep_ = 0; rep_ < ((PROBE_DOUBLE == (k)) ? 2 : 1); ++rep_)
#define IN(k) (lo <= (k) && (k) < hi)
#define BOTH(k) (IN(k) && IN((k) + 1))
    bf16* XN = (bf16*)(F.ws + WS_XN);
    if (IN(0)) REP(0) { p0_prologue(F, args); if (BOTH(0)) GRID_BAR(); }
    STAMP(1);
    if (IN(1)) REP(1) { p1_lnmod(F, args); if (BOTH(1)) GRID_BAR(); }
    STAMP(2);
    if (IN(2)) REP(2) {
        __syncthreads();
        pg8::Gemm g{XN, (const bf16*)(F.ws + WS_WIN), M, PJ, D}; pg8::StaticOrder So; So.init(M, PJ, F.G, (int)blockIdx.x);
        pg8::EpiQKVP E{(bf16*)(F.ws + WS_Q), (size_t)M * SBW, QSCALE};
        pg8::gemm_phase<pg8::EpiQKVP, pg8::StaticOrder, PG8_ALIGN, PG8_SP2>(F.lds + RING_OFF, g, So, E);
        if (BOTH(2)) GRID_BAR();
    }
    STAMP(3);
    if (IN(3)) REP(3) { __syncthreads(); p3_attn_pool(F, args); if (BOTH(3)) GRID_BAR(); }
    STAMP(4);
    if (IN(4)) REP(4) {
        __syncthreads();
        pg8::Gemm g{(const bf16*)(F.ws + WS_AO), (const bf16*)(F.ws + WS_WOUT), M, D, D}; pg8::StaticOrder So; So.init(M, D, F.G, (int)blockIdx.x);
        pg8::EpiMix E{(bf16*)(F.ws + WS_MIX), (const float*)(F.ws + WS_MOD) + 2048};
        pg8::gemm_phase<pg8::EpiMix, pg8::StaticOrder, PG8_ALIGN, PG8_SP2>(F.lds + RING_OFF, g, So, E);
        if (BOTH(4)) GRID_BAR();
    }
    STAMP(5);
    if (IN(5)) { if (PROBE_DOUBLE == 5) { __syncthreads(); p5_post(F, args, true); GRID_BAR(); } __syncthreads(); p5_post(F, args); if (BOTH(5)) GRID_BAR(); }
    STAMP(6);
    if (IN(6)) REP(6) { p6_gather(F); if (BOTH(6)) GRID_BAR(); }
    STAMP(7);
    if (IN(7)) REP(7) {
        __syncthreads();
        int tstart, tend, total; moe_tiles(F, tstart, tend, total);
        pg8::Gemm g{(const bf16*)(F.ws + WS_XS), (const bf16*)(F.ws + WS_WGU), SORT_ROWS, NE * 1024, D};
        pg8::MoeOrder So{tend, total, F.G, F.vcu, F.lane};
        pg8::EpiGateUp E{(bf16*)(F.ws + WS_HS)};
        pg8::gemm_phase<pg8::EpiGateUp, pg8::MoeOrder, PG8_ALIGN, PG8_SP2>(F.lds + RING_OFF, g, So, E);
        if (BOTH(7)) GRID_BAR();
    }
    STAMP(8);
    if (IN(8)) REP(8) {
        __syncthreads();
        int tstart, tend, total; moe_tiles(F, tstart, tend, total);
        pg8::Gemm g{(const bf16*)(F.ws + WS_HS), (const bf16*)(F.ws + WS_WD), SORT_ROWS, NE * 1024, EH};
        pg8::MoeOrder So{tend, total, F.G, F.vcu, F.lane};
        pg8::EpiDown E{(bf16*)(F.ws + WS_XS)};
        pg8::gemm_phase<pg8::EpiDown, pg8::MoeOrder, PG8_ALIGN, PG8_SP2>(F.lds + RING_OFF, g, So, E);
        if (BOTH(8)) GRID_BAR();
    }
    STAMP(9);
    if (IN(9)) { if (PROBE_DOUBLE == 9) { p9_final(F, args, true); GRID_BAR(); } p9_final(F, args); }
    STAMP(10);
    if (PROBE_STAMP >= 0 && blockIdx.x == 0 && F.tid == 0) { VM_WAIT(); F.out[0] += (float)(F.tb - F.ta) * 0.001f; }
#undef IN
#undef BOTH
}

extern "C" void kernel_launch(void* const* d_in, const int* in_sizes, int n_in, void* d_out, int out_size, void* d_ws, size_t ws_size, hipStream_t stream) {
    static int grid = 0;
    if (grid == 0) {
        if (n_in != 19 || in_sizes[0] != M * D || out_size != M * D || ws_size < WS_END) { fprintf(stderr, "kernel_launch: unexpected problem (n_in %d, out %d, ws %zu); nothing launched\n", n_in, out_size, ws_size); grid = -1; return; }
        int dev = 0, cus = 0, per_cu = 0;
        if (hipGetDevice(&dev) != hipSuccess || hipDeviceGetAttribute(&cus, hipDeviceAttributeMultiprocessorCount, dev) != hipSuccess) { fprintf(stderr, "kernel_launch: device query failed\n"); grid = -1; return; }
        if (hipFuncSetAttribute((const void*)mk_fwd, hipFuncAttributeMaxDynamicSharedMemorySize, LDS_BYTES) != hipSuccess) { fprintf(stderr, "kernel_launch: hipFuncSetAttribute failed\n"); grid = -1; return; }
        if (hipOccupancyMaxActiveBlocksPerMultiprocessor(&per_cu, (const void*)mk_fwd, NWAVES * 64, LDS_BYTES) != hipSuccess || per_cu < 1) { fprintf(stderr, "kernel_launch: occupancy query says %d workgroups per CU; nothing launched\n", per_cu); (void)hipGetLastError(); grid = -1; return; }
        grid = cus;
    }
    if (grid < 0) return;
    if (hipMemsetAsync((char*)d_ws + WS_CTL, 0, CTL_ZERO_BYTES, stream) != hipSuccess) { fprintf(stderr, "kernel_launch: memset failed\n"); return; }
    Args a{};
    for (int i = 0; i < 19; ++i) a.in[i] = (const float*)d_in[i];
    a.out = (float*)d_out; a.ws = (unsigned char*)d_ws;
    for (int li = 0; li < N_LAUNCHES; ++li) {
        a.ph_lo = (N_LAUNCHES == 1) ? 0 : li; a.ph_hi = (N_LAUNCHES == 1) ? N_PHASES : li + 1; a.li = li;
        hipLaunchKernelGGL(mk_fwd, dim3(grid), dim3(NWAVES * 64), LDS_BYTES, stream, a);
        const hipError_t le = hipPeekAtLastError();
        if (le != hipSuccess) { fprintf(stderr, "kernel_launch: launch %d failed: %s\n", li, hipGetErrorName(le)); break; }
    }
}
```

```cpp
#include <hip/hip_runtime.h>
#include <cstdio>
#include <cstdint>
#include <cmath>
namespace pg8 {
#define PG8_LAS __attribute__((address_space(3)))
typedef unsigned short bf16_t;
typedef short bf16x8 __attribute__((ext_vector_type(8)));
typedef float f32x4 __attribute__((ext_vector_type(4)));
typedef unsigned u32x4 __attribute__((ext_vector_type(4)));
constexpr int BM = 256, BK = 64, HALF = 128, HTB = HALF * BK * 2  , STAGE_BYTES = 8 * HTB, NXCD = 8, WGM = 8;

__host__ __device__ __forceinline__ int lds_byte(int r, int c) { const int st = (r >> 4) * 2 + (c >> 5), rr = r & 15, cc = c & 31, ob = rr * 64 + cc * 2; return st * 1024 + (ob ^ (((ob >> 9) & 1) << 5)); }
__host__ __device__ __forceinline__ void stage_rc(int b, int& R, int& C) { const int st = b / 1024, sb = b % 1024, swz = sb ^ (((sb >> 9) & 1) << 5); R = (st >> 1) * 16 + swz / 64; C = (st & 1) * 32 + (swz % 64) / 2; }
__host__ __device__ __forceinline__ int perm32(int rho) { const int n = rho >> 4, i = rho & 15; return 8 * (i >> 2) + 4 * n + (i & 3); }

struct Unit { int pm, pn; };
struct Gemm { const bf16_t* A; const bf16_t* Bt; int M, N, K; };

struct StaticOrder {
    int nM, nN, nwg, G, c;
    __host__ __device__ void init(int M, int N, int G_, int c_) { nM = M / BM; nN = N / BM; nwg = nM * nN; G = G_; c = c_; }
    __host__ __device__ bool next(int i, Unit& u) const {
        const long L = (long)i * G + c; if (L >= nwg) return false;
        int wgid = (int)L; { const int q = nwg / NXCD, r = nwg % NXCD, xcd = wgid % NXCD, off = wgid / NXCD; wgid = (xcd < r ? xcd * (q + 1) : r * (q + 1) + (xcd - r) * q) + off; }
        const int nig = WGM * nN, gid = wgid / nig, fm = gid * WGM, gsz = (nM - fm) < WGM ? (nM - fm) : WGM;
        u.pm = fm + ((wgid % nig) % gsz); u.pn = (wgid % nig) / gsz; return true;
    }
    __device__ __forceinline__ void a_ready(const Unit&) const {}
    __device__ __forceinline__ void done(const Unit&) const {}
};


__device__ __forceinline__ unsigned cvt_pk_bf16(float lo, float hi) { unsigned r; asm volatile("v_cvt_pk_bf16_f32 %0, %1, %2" : "=v"(r) : "v"(lo), "v"(hi)); return r; }

struct EpiQKVP {
    static constexpr bool PERM = true, AFTER_DRAIN = false;
    bf16_t* O; size_t split_stride; float scale0;
    __device__ __forceinline__ void operator()(const f32x4 (&acc)[2][2][4][2], const Unit& u, int wr, int wc, int fr, int fq) const {
        const int row0 = u.pm * BM + wr * 64 + fr; const int t = u.pn >> 1; const int colt = (u.pn & 1) * BM;
        bf16_t* base = O + (size_t)t * split_stride; const float sc = (t == 0) ? scale0 : 1.f;
        const int col0 = colt + wc * 32 + 8 * fq;
#pragma unroll
        for (int ai = 0; ai < 2; ++ai)
#pragma unroll
            for (int m = 0; m < 4; ++m) { bf16_t* rowp = base + (size_t)(row0 + ai * HALF + m * 16) * 512 + col0;
#pragma unroll
                for (int bj = 0; bj < 2; ++bj) { const f32x4 v0 = acc[ai][bj][m][0] * sc, v1 = acc[ai][bj][m][1] * sc;
                    u32x4 w; w.x = cvt_pk_bf16(v0[0], v0[1]); w.y = cvt_pk_bf16(v0[2], v0[3]); w.z = cvt_pk_bf16(v1[0], v1[1]); w.w = cvt_pk_bf16(v1[2], v1[3]);
                    *(u32x4*)(rowp + bj * HALF) = w; } }
    }
};
struct EpiMix {
    static constexpr bool PERM = true, AFTER_DRAIN = false;
    bf16_t* O; const float* gate;
    __device__ __forceinline__ void operator()(const f32x4 (&acc)[2][2][4][2], const Unit& u, int wr, int wc, int fr, int fq) const {
        const int row0 = u.pm * BM + wr * 64 + fr, col0 = u.pn * BM + wc * 32 + 8 * fq;
        const int b = (u.pm * BM) >> 12;
        f32x4 gv[2][2];
#pragma unroll
        for (int bj = 0; bj < 2; ++bj)
#pragma unroll
            for (int n = 0; n < 2; ++n) gv[bj][n] = *(const f32x4*)(gate + b * 6144 + col0 + bj * HALF + 4 * n) + 1.0f;
#pragma unroll
        for (int ai = 0; ai < 2; ++ai)
#pragma unroll
            for (int m = 0; m < 4; ++m) { bf16_t* rowp = O + (size_t)(row0 + ai * HALF + m * 16) * 1024 + col0;
#pragma unroll
                for (int bj = 0; bj < 2; ++bj) { const f32x4 v0 = acc[ai][bj][m][0] * gv[bj][0], v1 = acc[ai][bj][m][1] * gv[bj][1];
                    u32x4 w; w.x = cvt_pk_bf16(v0[0], v0[1]); w.y = cvt_pk_bf16(v0[2], v0[3]); w.z = cvt_pk_bf16(v1[0], v1[1]); w.w = cvt_pk_bf16(v1[2], v1[3]);
                    *(u32x4*)(rowp + bj * HALF) = w; } }
    }
};
__device__ __forceinline__ float silu_f(float g) { return g * __builtin_amdgcn_rcpf(1.0f + __builtin_amdgcn_exp2f(g * -1.4426950408889634f)); }
struct EpiGateUp {
    static constexpr bool PERM = true, AFTER_DRAIN = false;
    bf16_t* H;
    __device__ __forceinline__ void operator()(const f32x4 (&acc)[2][2][4][2], const Unit& u, int wr, int wc, int fr, int fq) const {
        const int row0 = u.pm * BM + wr * 64 + fr, col0 = (u.pn & 3) * 128 + wc * 32 + 8 * fq;
#pragma unroll
        for (int ai = 0; ai < 2; ++ai)
#pragma unroll
            for (int m = 0; m < 4; ++m) { bf16_t* rowp = H + (size_t)(row0 + ai * HALF + m * 16) * 512 + col0;
                const f32x4 g0 = acc[ai][0][m][0], g1 = acc[ai][0][m][1], u0 = acc[ai][1][m][0], u1 = acc[ai][1][m][1];
                u32x4 w;
                w.x = cvt_pk_bf16(silu_f(g0[0]) * u0[0], silu_f(g0[1]) * u0[1]); w.y = cvt_pk_bf16(silu_f(g0[2]) * u0[2], silu_f(g0[3]) * u0[3]);
                w.z = cvt_pk_bf16(silu_f(g1[0]) * u1[0], silu_f(g1[1]) * u1[1]); w.w = cvt_pk_bf16(silu_f(g1[2]) * u1[2], silu_f(g1[3]) * u1[3]);
                *(u32x4*)rowp = w; }
    }
};
struct EpiDown {
    static constexpr bool PERM = true, AFTER_DRAIN = false;
    bf16_t* Y;
    __device__ __forceinline__ void operator()(const f32x4 (&acc)[2][2][4][2], const Unit& u, int wr, int wc, int fr, int fq) const {
        const int row0 = u.pm * BM + wr * 64 + fr, col0 = (u.pn & 3) * BM + wc * 32 + 8 * fq;
#pragma unroll
        for (int ai = 0; ai < 2; ++ai)
#pragma unroll
            for (int m = 0; m < 4; ++m) { bf16_t* rowp = Y + (size_t)(row0 + ai * HALF + m * 16) * 1024 + col0;
#pragma unroll
                for (int bj = 0; bj < 2; ++bj) { const f32x4 v0 = acc[ai][bj][m][0], v1 = acc[ai][bj][m][1];
                    u32x4 w; w.x = cvt_pk_bf16(v0[0], v0[1]); w.y = cvt_pk_bf16(v0[2], v0[3]); w.z = cvt_pk_bf16(v1[0], v1[1]); w.w = cvt_pk_bf16(v1[2], v1[3]);
                    *(u32x4*)(rowp + bj * HALF) = w; } }
    }
};
struct MoeOrder {
    int tstart, tend, cnt, total, G, c, lane; const int* idx;
    __device__ __forceinline__ bool next(int i, Unit& u) const {
        const int L = i * G + c, mt = L >> 2; if (mt >= total) return false;
        const unsigned long long bal = __ballot(lane < 16 && mt >= tend);
        u.pm = mt; u.pn = (int)__popcll(bal) * 4 + (L & 3); return true;
    }
    __device__ __forceinline__ void a_rows(const Unit& u, const int (&RA)[2], int CA, int K, unsigned (&v)[2][2]) const {
        const int e = u.pn >> 2;
        const int ts = __builtin_amdgcn_readlane(tstart, e), ne = __builtin_amdgcn_readlane(cnt, e);
        const int p0 = (u.pm - ts) * 256;
#pragma unroll
        for (int h = 0; h < 2; ++h)
#pragma unroll
            for (int i = 0; i < 2; ++i) { int pos = p0 + h * 128 + RA[i]; pos = pos < ne ? pos : ne - 1;
                v[h][i] = (unsigned)idx[e * 16384 + pos] * (unsigned)(K * 2) + (unsigned)(CA * 2); }
    }
    __device__ __forceinline__ void a_ready(const Unit&) const {}
    __device__ __forceinline__ void done(const Unit&) const {}
};

template <class Epi, class Sched, bool ALIGN_EPI = false, bool SP2 = false>
__device__ __forceinline__ void gemm_phase(PG8_LAS unsigned char* lds, const Gemm g, const Sched& S, const Epi& E) {
    const int tid = threadIdx.x, wid = __builtin_amdgcn_readfirstlane(tid >> 6), lane = tid & 63, wr = wid >> 2, wc = wid & 3, fr = lane & 15, fq = lane >> 4;
    const int K = g.K, nt = K / BK;
    unsigned voffA[2], voffB[2];
#pragma unroll
    for (int i = 0; i < 2; ++i) { int R, C; stage_rc(tid * 16 + i * 8192, R, C); const int Rb = Epi::PERM ? ((R & ~31) + perm32(R & 31)) : R;
        voffA[i] = (unsigned)(R * K + C) * 2u; voffB[i] = (unsigned)(Rb * K + C) * 2u; }
    const size_t kstep = (size_t)(BK * 2);
    const size_t hstep = (size_t)HALF * K * 2;
    const size_t tstep = 2 * hstep;
    const unsigned ldsw = (unsigned)wid * 1024u;
    const int aoff = lds_byte(wr * 64 + fr, fq * 8), boff = lds_byte(wc * 32 + fr, fq * 8);
#define PG8_SA(b, h) (((b) * 2 + (h)) * HTB)
#define PG8_SB(b, h) ((4 + (b) * 2 + (h)) * HTB)
#define PG8_STAGE(bufoff, gbase, voff) do { _Pragma("unroll") for (int _i = 0; _i < 2; ++_i) \
        __builtin_amdgcn_global_load_lds((const unsigned*)((const char*)(gbase) + (voff)[_i]), (PG8_LAS unsigned*)(lds + (bufoff) + ldsw + _i * 8192), 16, 0, 0); } while (0)
#define PG8_LDA(dst, b, h) do { _Pragma("unroll") for (int m = 0; m < 4; ++m) _Pragma("unroll") for (int k = 0; k < 2; ++k) dst[m][k] = *(const PG8_LAS bf16x8*)(lds + PG8_SA(b, h) + aoff + m * 2048 + k * 1024); } while (0)
#define PG8_LDB(dst, b, h) do { _Pragma("unroll") for (int n = 0; n < 2; ++n) _Pragma("unroll") for (int k = 0; k < 2; ++k) dst[n][k] = *(const PG8_LAS bf16x8*)(lds + PG8_SB(b, h) + boff + n * 2048 + k * 1024); } while (0)
#define PG8_MMA(ai, bj, At, Bt) do { __builtin_amdgcn_s_setprio(1); _Pragma("unroll") for (int m = 0; m < 4; ++m) _Pragma("unroll") for (int n = 0; n < 2; ++n) _Pragma("unroll") for (int k = 0; k < 2; ++k) \
        acc[ai][bj][m][n] = __builtin_amdgcn_mfma_f32_16x16x32_bf16(Bt[n][k], At[m][k], acc[ai][bj][m][n], 0, 0, 0); __builtin_amdgcn_s_setprio(0); } while (0)
#define PG8_WAIT_V(n) asm volatile("s_waitcnt vmcnt(" #n ")" ::: "memory")
#define PG8_WAIT_L(n) asm volatile("s_waitcnt lgkmcnt(" #n ")" ::: "memory")
#define PG8_BAR __builtin_amdgcn_s_barrier()
#define PG8_SCHED __builtin_amdgcn_sched_barrier(0)
    Unit cur, nxt; int ui = 0;
    if (!S.next(0, cur)) return;
    f32x4 acc[2][2][4][2];
#pragma unroll
    for (int a = 0; a < 2; ++a)
#pragma unroll
        for (int b = 0; b < 2; ++b)
#pragma unroll
            for (int m = 0; m < 4; ++m)
#pragma unroll
                for (int n = 0; n < 2; ++n) acc[a][b][m][n] = (f32x4){0.f, 0.f, 0.f, 0.f};
    bf16x8 At[4][2], B0[2][2], B1[2][2];
    const char* cA = (const char*)g.A + (size_t)cur.pm * tstep; const char* cB = (const char*)g.Bt + (size_t)cur.pn * tstep;
    S.a_ready(cur);
    if constexpr (SP2) {
        PG8_STAGE(PG8_SB(0, 0), cB, voffB); PG8_STAGE(PG8_SB(0, 1), cB + hstep, voffB); PG8_STAGE(PG8_SA(0, 0), cA, voffA); PG8_STAGE(PG8_SA(0, 1), cA + hstep, voffA);
        if (wr == 1) PG8_BAR;
        PG8_WAIT_V(2); PG8_BAR;
        PG8_STAGE(PG8_SB(1, 0), cB + kstep, voffB); PG8_STAGE(PG8_SA(1, 0), cA + kstep, voffA); PG8_STAGE(PG8_SB(1, 1), cB + hstep + kstep, voffB);
        PG8_WAIT_V(6); PG8_BAR;
    } else {
        PG8_STAGE(PG8_SB(0, 0), cB, voffB); PG8_STAGE(PG8_SA(0, 0), cA, voffA); PG8_STAGE(PG8_SB(0, 1), cB + hstep, voffB); PG8_STAGE(PG8_SA(0, 1), cA + hstep, voffA);
        if (wr == 1) PG8_BAR;
        PG8_WAIT_V(4); PG8_BAR;
        PG8_STAGE(PG8_SB(1, 0), cB + kstep, voffB); PG8_STAGE(PG8_SA(1, 0), cA + kstep, voffA); PG8_STAGE(PG8_SB(1, 1), cB + hstep + kstep, voffB);
        PG8_WAIT_V(6); PG8_BAR;
    }
    for (;;) {
        const bool has_next = S.next(ui + 1, nxt);
        const char* nA = has_next ? (const char*)g.A + (size_t)nxt.pm * tstep : cA; const char* nB = has_next ? (const char*)g.Bt + (size_t)nxt.pn * tstep : cB;
        for (int t = 0; t < nt; t += 2) {
            const bool last = (t == nt - 2);
            const char* a1 = cA + (size_t)(t + 1) * kstep;
            const char* a2 = last ? nA : cA + (size_t)(t + 2) * kstep; const char* b2 = last ? nB : cB + (size_t)(t + 2) * kstep;
            const char* a3 = a2 + kstep; const char* b3 = b2 + kstep;
            if (last && has_next) S.a_ready(nxt);
            if constexpr (SP2) {
            PG8_LDB(B0, 0, 0); PG8_LDB(B1, 0, 1); PG8_SCHED; PG8_LDA(At, 0, 0); PG8_STAGE(PG8_SA(1, 1), a1 + hstep, voffA);
            PG8_WAIT_V(8); PG8_WAIT_L(0); PG8_BAR; PG8_MMA(0, 0, At, B0); PG8_MMA(0, 1, At, B1); PG8_BAR; PG8_SCHED;
            PG8_LDA(At, 0, 1); PG8_STAGE(PG8_SB(0, 0), b2, voffB); PG8_STAGE(PG8_SB(0, 1), b2 + hstep, voffB); PG8_STAGE(PG8_SA(0, 0), a2, voffA);
            PG8_WAIT_V(8); PG8_WAIT_L(0); PG8_BAR; PG8_MMA(1, 0, At, B0); PG8_MMA(1, 1, At, B1); PG8_BAR; PG8_SCHED;
            PG8_LDB(B0, 1, 0); PG8_LDB(B1, 1, 1); PG8_SCHED; PG8_LDA(At, 1, 0); PG8_STAGE(PG8_SA(0, 1), a2 + hstep, voffA);
            PG8_WAIT_V(8); PG8_WAIT_L(0); PG8_BAR; PG8_MMA(0, 0, At, B0); PG8_MMA(0, 1, At, B1); PG8_BAR; PG8_SCHED;
            PG8_LDA(At, 1, 1); PG8_STAGE(PG8_SB(1, 0), b3, voffB); PG8_STAGE(PG8_SB(1, 1), b3 + hstep, voffB); PG8_STAGE(PG8_SA(1, 0), a3, voffA);
            PG8_WAIT_V(8); PG8_WAIT_L(0); PG8_BAR; PG8_MMA(1, 0, At, B0); PG8_MMA(1, 1, At, B1); PG8_BAR; PG8_SCHED;
            } else {
            PG8_LDB(B0, 0, 0); PG8_SCHED; PG8_LDA(At, 0, 0); PG8_STAGE(PG8_SA(1, 1), a1 + hstep, voffA);
            PG8_WAIT_L(8); PG8_BAR; PG8_WAIT_L(0); PG8_MMA(0, 0, At, B0); PG8_BAR; PG8_SCHED;
            PG8_LDB(B1, 0, 1); PG8_STAGE(PG8_SB(0, 0), b2, voffB);
            PG8_BAR; PG8_WAIT_L(0); PG8_MMA(0, 1, At, B1); PG8_BAR;
            PG8_LDA(At, 0, 1); PG8_STAGE(PG8_SA(0, 0), a2, voffA);
            PG8_BAR; PG8_WAIT_L(0); PG8_MMA(1, 0, At, B0); PG8_BAR; PG8_SCHED;
            PG8_STAGE(PG8_SB(0, 1), b2 + hstep, voffB);
            PG8_WAIT_V(6); PG8_BAR; PG8_MMA(1, 1, At, B1); PG8_BAR;
            PG8_LDB(B0, 1, 0); PG8_SCHED; PG8_LDA(At, 1, 0); PG8_STAGE(PG8_SA(0, 1), a2 + hstep, voffA);
            PG8_WAIT_L(8); PG8_BAR; PG8_WAIT_L(0); PG8_MMA(0, 0, At, B0); PG8_BAR; PG8_SCHED;
            PG8_LDB(B1, 1, 1); PG8_STAGE(PG8_SB(1, 0), b3, voffB);
            PG8_BAR; PG8_WAIT_L(0); PG8_MMA(0, 1, At, B1); PG8_BAR;
            PG8_LDA(At, 1, 1); PG8_STAGE(PG8_SA(1, 0), a3, voffA);
            PG8_BAR; PG8_WAIT_L(0); PG8_MMA(1, 0, At, B0); PG8_BAR; PG8_SCHED;
            PG8_STAGE(PG8_SB(1, 1), b3 + hstep, voffB);
            PG8_WAIT_V(6); PG8_BAR; PG8_MMA(1, 1, At, B1); PG8_BAR;
            }
        }
        if constexpr (ALIGN_EPI) { if (wr == 0) PG8_BAR; }
        if constexpr (!Epi::AFTER_DRAIN) { E(acc, cur, wr, wc, fr, fq); S.done(cur); }
        if (!has_next) break;
#pragma unroll
        for (int a = 0; a < 2; ++a)
#pragma unroll
            for (int b = 0; b < 2; ++b)
#pragma unroll
                for (int m = 0; m < 4; ++m)
#pragma unroll
                    for (int n = 0; n < 2; ++n) acc[a][b][m][n] = (f32x4){0.f, 0.f, 0.f, 0.f};
        cur = nxt; cA = nA; cB = nB; ++ui;
        if constexpr (ALIGN_EPI) { if (wr == 1) PG8_BAR; }
    }
    PG8_WAIT_V(0);
    if constexpr (!ALIGN_EPI) { if (wr == 0) PG8_BAR; }
    PG8_BAR;
    if constexpr (Epi::AFTER_DRAIN) { E.fused(acc, cur, wr, wc, fr, fq, lds, wid, lane); S.done(cur); }
#undef PG8_SA
#undef PG8_SB
#undef PG8_STAGE
#undef PG8_LDA
#undef PG8_LDB
#undef PG8_MMA
#undef PG8_WAIT_V
#undef PG8_WAIT_L
#undef PG8_BAR
#undef PG8_SCHED
}
template <class Epi, class Sched, bool ALIGN_EPI = false, bool SP2 = false>
__device__ __forceinline__ void gemm_phase_g(PG8_LAS unsigned char* lds, const Gemm g, const Sched& S, const Epi& E) {
    const int tid = threadIdx.x, wid = __builtin_amdgcn_readfirstlane(tid >> 6), lane = tid & 63, wr = wid >> 2, wc = wid & 3, fr = lane & 15, fq = lane >> 4;
    const int K = g.K, nt = K / BK;
    unsigned voffB[2]; unsigned vA[2][2], nvA[2][2]; int RA[2], CA = 0;
#pragma unroll
    for (int i = 0; i < 2; ++i) { int R, C; stage_rc(tid * 16 + i * 8192, R, C); const int Rb = Epi::PERM ? ((R & ~31) + perm32(R & 31)) : R;
        RA[i] = R; CA = C; voffB[i] = (unsigned)(Rb * K + C) * 2u; }
    const size_t kstep = (size_t)(BK * 2);
    const size_t hstep = (size_t)HALF * K * 2;
    const size_t tstep = 2 * hstep;
    const unsigned ldsw = (unsigned)wid * 1024u;
    const int aoff = lds_byte(wr * 64 + fr, fq * 8), boff = lds_byte(wc * 32 + fr, fq * 8);
#define PG8_SA(b, h) (((b) * 2 + (h)) * HTB)
#define PG8_SB(b, h) ((4 + (b) * 2 + (h)) * HTB)
#define PG8_STAGE(bufoff, gbase, voff) do { _Pragma("unroll") for (int _i = 0; _i < 2; ++_i) \
        __builtin_amdgcn_global_load_lds((const unsigned*)((const char*)(gbase) + (voff)[_i]), (PG8_LAS unsigned*)(lds + (bufoff) + ldsw + _i * 8192), 16, 0, 0); } while (0)
#define PG8_LDA(dst, b, h) do { _Pragma("unroll") for (int m = 0; m < 4; ++m) _Pragma("unroll") for (int k = 0; k < 2; ++k) dst[m][k] = *(const PG8_LAS bf16x8*)(lds + PG8_SA(b, h) + aoff + m * 2048 + k * 1024); } while (0)
#define PG8_LDB(dst, b, h) do { _Pragma("unroll") for (int n = 0; n < 2; ++n) _Pragma("unroll") for (int k = 0; k < 2; ++k) dst[n][k] = *(const PG8_LAS bf16x8*)(lds + PG8_SB(b, h) + boff + n * 2048 + k * 1024); } while (0)
#define PG8_MMA(ai, bj, At, Bt) do { __builtin_amdgcn_s_setprio(1); _Pragma("unroll") for (int m = 0; m < 4; ++m) _Pragma("unroll") for (int n = 0; n < 2; ++n) _Pragma("unroll") for (int k = 0; k < 2; ++k) \
        acc[ai][bj][m][n] = __builtin_amdgcn_mfma_f32_16x16x32_bf16(Bt[n][k], At[m][k], acc[ai][bj][m][n], 0, 0, 0); __builtin_amdgcn_s_setprio(0); } while (0)
#define PG8_WAIT_V(n) asm volatile("s_waitcnt vmcnt(" #n ")" ::: "memory")
#define PG8_WAIT_L(n) asm volatile("s_waitcnt lgkmcnt(" #n ")" ::: "memory")
#define PG8_BAR __builtin_amdgcn_s_barrier()
#define PG8_SCHED __builtin_amdgcn_sched_barrier(0)
    Unit cur, nxt; int ui = 0;
    if (!S.next(0, cur)) return;
    f32x4 acc[2][2][4][2];
#pragma unroll
    for (int a = 0; a < 2; ++a)
#pragma unroll
        for (int b = 0; b < 2; ++b)
#pragma unroll
            for (int m = 0; m < 4; ++m)
#pragma unroll
                for (int n = 0; n < 2; ++n) acc[a][b][m][n] = (f32x4){0.f, 0.f, 0.f, 0.f};
    bf16x8 At[4][2], B0[2][2], B1[2][2];
    const char* cA = (const char*)g.A; const char* cB = (const char*)g.Bt + (size_t)cur.pn * tstep;
    S.a_rows(cur, RA, CA, K, vA);
    S.a_ready(cur);
    if constexpr (SP2) {
        PG8_STAGE(PG8_SB(0, 0), cB, voffB); PG8_STAGE(PG8_SB(0, 1), cB + hstep, voffB); PG8_STAGE(PG8_SA(0, 0), cA, vA[0]); PG8_STAGE(PG8_SA(0, 1), cA, vA[1]);
        if (wr == 1) PG8_BAR;
        PG8_WAIT_V(2); PG8_BAR;
        PG8_STAGE(PG8_SB(1, 0), cB + kstep, voffB); PG8_STAGE(PG8_SA(1, 0), cA + kstep, vA[0]); PG8_STAGE(PG8_SB(1, 1), cB + hstep + kstep, voffB);
        PG8_WAIT_V(6); PG8_BAR;
    }
    for (;;) {
        const bool has_next = S.next(ui + 1, nxt);
        const char* nA = cA; const char* nB = has_next ? (const char*)g.Bt + (size_t)nxt.pn * tstep : cB;
        if (has_next) S.a_rows(nxt, RA, CA, K, nvA); else { nvA[0][0] = vA[0][0]; nvA[0][1] = vA[0][1]; nvA[1][0] = vA[1][0]; nvA[1][1] = vA[1][1]; }
        for (int t = 0; t < nt; t += 2) {
            const bool last = (t == nt - 2);
            const char* a1 = cA + (size_t)(t + 1) * kstep;
            const char* a2 = last ? nA : cA + (size_t)(t + 2) * kstep; const char* b2 = last ? nB : cB + (size_t)(t + 2) * kstep;
            const char* a3 = a2 + kstep; const char* b3 = b2 + kstep;
            const unsigned w0[2] = {last ? nvA[0][0] : vA[0][0], last ? nvA[0][1] : vA[0][1]}, w1[2] = {last ? nvA[1][0] : vA[1][0], last ? nvA[1][1] : vA[1][1]};
            if (last && has_next) S.a_ready(nxt);
            if constexpr (SP2) {
            PG8_LDB(B0, 0, 0); PG8_LDB(B1, 0, 1); PG8_SCHED; PG8_LDA(At, 0, 0); PG8_STAGE(PG8_SA(1, 1), a1, vA[1]);
            PG8_WAIT_V(8); PG8_WAIT_L(0); PG8_BAR; PG8_MMA(0, 0, At, B0); PG8_MMA(0, 1, At, B1); PG8_BAR; PG8_SCHED;
            PG8_LDA(At, 0, 1); PG8_STAGE(PG8_SB(0, 0), b2, voffB); PG8_STAGE(PG8_SB(0, 1), b2 + hstep, voffB); PG8_STAGE(PG8_SA(0, 0), a2, w0);
            PG8_WAIT_V(8); PG8_WAIT_L(0); PG8_BAR; PG8_MMA(1, 0, At, B0); PG8_MMA(1, 1, At, B1); PG8_BAR; PG8_SCHED;
            PG8_LDB(B0, 1, 0); PG8_LDB(B1, 1, 1); PG8_SCHED; PG8_LDA(At, 1, 0); PG8_STAGE(PG8_SA(0, 1), a2, w1);
            PG8_WAIT_V(8); PG8_WAIT_L(0); PG8_BAR; PG8_MMA(0, 0, At, B0); PG8_MMA(0, 1, At, B1); PG8_BAR; PG8_SCHED;
            PG8_LDA(At, 1, 1); PG8_STAGE(PG8_SB(1, 0), b3, voffB); PG8_STAGE(PG8_SB(1, 1), b3 + hstep, voffB); PG8_STAGE(PG8_SA(1, 0), a3, w0);
            PG8_WAIT_V(8); PG8_WAIT_L(0); PG8_BAR; PG8_MMA(1, 0, At, B0); PG8_MMA(1, 1, At, B1); PG8_BAR; PG8_SCHED;
            }
        }
        if constexpr (ALIGN_EPI) { if (wr == 0) PG8_BAR; }
        if constexpr (!Epi::AFTER_DRAIN) { E(acc, cur, wr, wc, fr, fq); S.done(cur); }
        if (!has_next) break;
#pragma unroll
        for (int a = 0; a < 2; ++a)
#pragma unroll
            for (int b = 0; b < 2; ++b)
#pragma unroll
                for (int m = 0; m < 4; ++m)
#pragma unroll
                    for (int n = 0; n < 2; ++n) acc[a][b][m][n] = (f32x4){0.f, 0.f, 0.f, 0.f};
        cur = nxt; cA = nA; cB = nB; ++ui; vA[0][0] = nvA[0][0]; vA[0][1] = nvA[0][1]; vA[1][0] = nvA[1][0]; vA[1][1] = nvA[1][1];
        if constexpr (ALIGN_EPI) { if (wr == 1) PG8_BAR; }
    }
    PG8_WAIT_V(0);
    if constexpr (!ALIGN_EPI) { if (wr == 0) PG8_BAR; }
    PG8_BAR;
    if constexpr (Epi::AFTER_DRAIN) { E.fused(acc, cur, wr, wc, fr, fq, lds, wid, lane); S.done(cur); }
#undef PG8_SA
#undef PG8_SB
#undef PG8_STAGE
#undef PG8_LDA
#undef PG8_LDB
#undef PG8_MMA
#undef PG8_WAIT_V
#undef PG8_WAIT_L
#undef PG8_BAR
#undef PG8_SCHED
}
}


#ifndef PG8_SP2
#define PG8_SP2 true
#endif
#ifndef PG8_ALIGN
#define PG8_ALIGN true
#endif
#ifndef MK_N_LAUNCHES
#define MK_N_LAUNCHES 1
#endif

constexpr int NWAVES = 8;
constexpr int NB = 4, S = 4096, D = 1024, M = NB * S;
constexpr int NH = 8, SBW = 512, PJ = 2048, NE = 16, EH = 512;
constexpr float ALPHA = 1.189207115002721f;
constexpr float LN_EPS = 1e-5f;
constexpr float QSCALE = 0.125f * 1.4426950408889634f;
constexpr int N_PHASES = 10;
constexpr int N_LAUNCHES = MK_N_LAUNCHES;
constexpr int SORT_ROWS = 2 * M + NE * 256;

constexpr size_t MiB = 1u << 20;
constexpr size_t WS_CTL = 0, CTL_ZERO_BYTES = 1 * MiB;
constexpr size_t WS_MODP = 1 * MiB;
constexpr size_t WS_MOD = 2 * MiB;
constexpr size_t WS_IDX = 3 * MiB;
constexpr size_t WS_ROUTE = 4 * MiB;
constexpr size_t WS_WIN = 8 * MiB;
constexpr size_t WS_WOUT = 12 * MiB;
constexpr size_t WS_WGU = 16 * MiB;
constexpr size_t WS_WD = 48 * MiB;
constexpr size_t WS_XN = 64 * MiB;
constexpr size_t WS_Q = 96 * MiB;
constexpr size_t WS_AO = 160 * MiB;
constexpr size_t WS_MIX = 96 * MiB;
constexpr size_t WS_XS = 96 * MiB;
constexpr size_t WS_HS = 168 * MiB;
constexpr size_t WS_END = 204 * MiB;
static_assert(WS_XS + (size_t)SORT_ROWS * 1024 * 2 <= WS_HS && WS_HS + (size_t)SORT_ROWS * 512 * 2 <= WS_END, "d_ws map");
constexpr int CW_TMO = 0, CW_CODE = 1, CW_BAR = 4096, CW_CNT = 16384;

constexpr int RING_OFF = 0, RING_BYTES = 131072;
constexpr int LDS_BYTES = 163840;
constexpr int LDSCTL_OFF = LDS_BYTES - 1024, MISC_OFF = LDSCTL_OFF + 320;
constexpr int WSCR = 16896, SIL_OFF = 139264;

#define GAS __attribute__((address_space(1)))
#define LAS __attribute__((address_space(3)))
typedef unsigned short bf16;
typedef unsigned v4u __attribute__((ext_vector_type(4)));
typedef unsigned v2u __attribute__((ext_vector_type(2)));
typedef float f32x4 __attribute__((ext_vector_type(4)));
typedef float f32x16 __attribute__((ext_vector_type(16)));
typedef short bf16x8 __attribute__((ext_vector_type(8)));
typedef short s16x4 __attribute__((ext_vector_type(4)));
typedef GAS unsigned gu32;
#define RLX_AGENT __ATOMIC_RELAXED, __HIP_MEMORY_SCOPE_AGENT
#define LDS_WAIT() asm volatile("s_waitcnt lgkmcnt(0)" ::: "memory")
#define VM_WAIT() asm volatile("s_waitcnt vmcnt(0)" ::: "memory")
__device__ __forceinline__ unsigned f2bf(float f) { unsigned u = __builtin_bit_cast(unsigned, f); return (u + 0x7fffu + ((u >> 16) & 1u)) >> 16; }
typedef float f32x2_t __attribute__((ext_vector_type(2))); typedef __bf16 bf16x2_t __attribute__((ext_vector_type(2)));
__device__ __forceinline__ unsigned pk2(float lo, float hi) { const f32x2_t v = {lo, hi}; return __builtin_bit_cast(unsigned, __builtin_convertvector(v, bf16x2_t)); }
__device__ __forceinline__ float bf_lo(unsigned w) { return __builtin_bit_cast(float, w << 16); }
__device__ __forceinline__ float bf_hi(unsigned w) { return __builtin_bit_cast(float, w & 0xffff0000u); }

#define XB_TMO      128
#define XB_XCNT(j)  (256  + 64 * (j))
#define XB_XSUB(j)  (1280 + 64 * (j))
#define XB_XGEN(j)  (2304 + 64 * (j))
#define XB_TOP      3328
#define XB_TOPGEN   3392
#define XCD_BAR_WORDS 3456
#define XB_SPIN_CAP (1u << 18)

__device__ __forceinline__ unsigned xb_ld(unsigned* p)              { return __hip_atomic_load(p, __ATOMIC_RELAXED, __HIP_MEMORY_SCOPE_AGENT); }
__device__ __forceinline__ unsigned xb_add(unsigned* p, unsigned v) { return __hip_atomic_fetch_add(p, v, __ATOMIC_RELAXED, __HIP_MEMORY_SCOPE_AGENT); }
__device__ __forceinline__ unsigned xb_xcc_id() { return (unsigned)__builtin_amdgcn_s_getreg((3 << 11) | 20) & 0xFu; }
#define XB_SPIN(cond, bar) do { unsigned _sp = 0; while (cond) { __builtin_amdgcn_s_sleep(1); \
    if ((++_sp & 255u) == 0u) { if (xb_ld(&(bar)[XB_TMO])) break; if (_sp > XB_SPIN_CAP) { atomicAdd(&(bar)[XB_TMO], 1u); break; } } } } while (0)

struct XcdBarrier {
    unsigned* bar; unsigned x;
    volatile LAS unsigned* st;
};

__device__ __forceinline__ XcdBarrier xcd_barrier_post(unsigned* bar, volatile LAS unsigned* st) {
    XcdBarrier b; b.bar = bar; b.x = xb_xcc_id(); b.st = st;
    if (threadIdx.x == 0) (void)xb_add(&bar[XB_XCNT(b.x)], 1u);
    return b;
}
__device__ __forceinline__ void xcd_barrier_complete(unsigned* bar, unsigned x, unsigned& nloc, unsigned& nx) {
    const unsigned G = gridDim.x * gridDim.y * gridDim.z;
    unsigned sum, cnt, mine, sp = 0u;
    for (;;) {
        sum = 0u; cnt = 0u; mine = 0u;
#pragma unroll
        for (unsigned j = 0; j < 16; ++j) { const unsigned c = xb_ld(&bar[XB_XCNT(j)]); sum += c; cnt += (c > 0u) ? 1u : 0u; mine = (j == x) ? c : mine; }
        if (sum == G) break;
        __builtin_amdgcn_s_sleep(1);
        if ((++sp & 255u) == 0u) { if (xb_ld(&bar[XB_TMO])) break; if (sp > XB_SPIN_CAP) { atomicAdd(&bar[XB_TMO], 1u); break; } }
    }
    nloc = mine > 0u ? mine : 1u; nx = cnt > 0u ? cnt : 1u;
}

__device__ __forceinline__ void xcd_barrier(const XcdBarrier& b) {
    asm volatile("s_waitcnt vmcnt(0)" ::: "memory");
    __syncthreads();
    if (threadIdx.x == 0) {
        unsigned* bar = b.bar;
        __builtin_amdgcn_s_waitcnt(0);
        unsigned nloc = b.st[0], nx = b.st[1];
        if (nloc == 0u) { xcd_barrier_complete(bar, b.x, nloc, nx); b.st[0] = nloc; b.st[1] = nx; }
        const unsigned old = xb_add(&bar[XB_XSUB(b.x)], 1u);
        const unsigned gen = old / nloc;
        if (old + 1u == (gen + 1u) * nloc) {
            __builtin_amdgcn_fence(__ATOMIC_RELEASE, "agent");
            asm volatile("s_waitcnt vmcnt(0)" ::: "memory");
            const unsigned og = xb_add(&bar[XB_TOP], 1u);
            const unsigned tg = og / nx;
            if (og + 1u == (tg + 1u) * nx) xb_add(&bar[XB_TOPGEN], 1u);
            else XB_SPIN(xb_ld(&bar[XB_TOPGEN]) == tg, bar);
            __builtin_amdgcn_fence(__ATOMIC_ACQUIRE, "agent");
            xb_add(&bar[XB_XGEN(b.x)], 1u);
            asm volatile("s_waitcnt vmcnt(0)" ::: "memory");
        } else {
            XB_SPIN(xb_ld(&bar[XB_XGEN(b.x)]) == gen, bar);
            __builtin_amdgcn_fence(__ATOMIC_ACQUIRE, "agent");
            asm volatile("s_waitcnt vmcnt(0)" ::: "memory");
        }
    }
    __syncthreads();
}

struct Args { const float* in[19]; float* out; unsigned char* ws; int ph_lo, ph_hi, li, pad; };
struct Frame {
    LAS unsigned char* lds;
    volatile LAS unsigned* MISC;
    gu32* ctl;
    int tid, lane, wave, vcu, G;
    float* out; unsigned char* ws;
    unsigned long long ta, tb;
};
#ifndef PROBE_STAMP
#define PROBE_STAMP -1
#endif
#ifndef STAMP_BX
#define STAMP_BX 64
#endif
#define SUBSTAMP(F, k) do { if (PROBE_STAMP >= 0 && blockIdx.x == STAMP_BX && (F).tid == 0) { const unsigned long long t_ = __builtin_amdgcn_s_memrealtime(); if ((k) == PROBE_STAMP) (F).ta = t_; if ((k) == PROBE_STAMP + 1) (F).tb = t_; } } while (0)
template <int CTRL> __device__ __forceinline__ float dpp_ror(float v) { return __builtin_bit_cast(float, __builtin_amdgcn_update_dpp(0, __builtin_bit_cast(int, v), CTRL, 0xf, 0xf, false)); }
__device__ __forceinline__ float wave_sum(float v) {
    v += dpp_ror<0x128>(v); v += dpp_ror<0x124>(v); v += dpp_ror<0x122>(v); v += dpp_ror<0x121>(v);
    const int x = __builtin_bit_cast(int, v);
    const float a = __builtin_bit_cast(float, __builtin_amdgcn_readlane(x, 0)), b = __builtin_bit_cast(float, __builtin_amdgcn_readlane(x, 16));
    const float c = __builtin_bit_cast(float, __builtin_amdgcn_readlane(x, 32)), d = __builtin_bit_cast(float, __builtin_amdgcn_readlane(x, 48));
    return (a + b) + (c + d);
}

__device__ __forceinline__ float row16_sum(float v) { v += dpp_ror<0x128>(v); v += dpp_ror<0x124>(v); v += dpp_ror<0x122>(v); v += dpp_ror<0x121>(v); return v; }

__device__ __forceinline__ void transpose_item(const float* W, int ldw, int k0, int n0, bf16* WT, size_t drow, int ldd, int dk0, LAS float* scr, int lane) {
    f32x4 v[16];
    const float* Wp = W + (size_t)(k0 + (lane >> 4)) * ldw + n0 + (lane & 15) * 4;
#pragma unroll
    for (int i = 0; i < 16; ++i) v[i] = *(const f32x4*)(Wp + (size_t)(4 * i) * ldw);
    LAS float* wb = scr + (lane >> 4) * 65 + (lane & 15) * 4;
#pragma unroll
    for (int i = 0; i < 16; ++i)
#pragma unroll
        for (int c = 0; c < 4; ++c) wb[i * 260 + c] = v[i][c];
    LDS_WAIT(); asm volatile("" ::: "memory");
    const int c8 = lane & 7;
    const LAS float* rb = scr + (8 * c8) * 65 + (lane >> 3);
    bf16* Wo = WT + (drow + (lane >> 3)) * ldd + dk0 + 8 * c8;
#pragma unroll
    for (int j = 0; j < 8; ++j) { float s[8];
#pragma unroll
        for (int t = 0; t < 8; ++t) s[t] = rb[t * 65 + 8 * j];
        v4u o; o.x = pk2(s[0], s[1]); o.y = pk2(s[2], s[3]); o.z = pk2(s[4], s[5]); o.w = pk2(s[6], s[7]);
        *(GAS v4u*)(Wo + (size_t)(8 * j) * ldd) = o; }
    LDS_WAIT(); asm volatile("" ::: "memory");
}
constexpr int I_ADA = 768, I_EFF = 1024, I_WIN = 512, I_WOUT = 128, I_EXP = 2048;
constexpr int P0_ITEMS = I_ADA + I_EFF + I_WIN + I_WOUT;
__device__ __forceinline__ void p0_prologue(Frame& F, const Args& A) {
    const float* c = A.in[1]; const float* w_ada = A.in[2]; const float* w_in = A.in[4]; const float* w_pool = A.in[5]; const float* pool_scale = A.in[6];
    const float* w_out = A.in[7];
    bf16* Win_t = (bf16*)(F.ws + WS_WIN); bf16* Wout_t = (bf16*)(F.ws + WS_WOUT);
    float* modp = (float*)(F.ws + WS_MODP);
    LAS float* scr = (LAS float*)(F.lds + F.wave * WSCR);
    LAS f32x4* sil = (LAS f32x4*)(F.lds + SIL_OFF);
    for (int k = F.tid; k < D; k += NWAVES * 64) { f32x4 v;
#pragma unroll
        for (int b = 0; b < 4; ++b) { const float cv = c[b * D + k]; v[b] = cv / (1.f + __expf(-cv)); }
        sil[k] = v; }
    __syncthreads();
    const int gw = F.vcu * NWAVES + F.wave, NGW = F.G * NWAVES, lane = F.lane;
    int sn_ = 60; SUBSTAMP(F, sn_); ++sn_;
    for (int it = gw; it < P0_ITEMS; it += NGW, ({ SUBSTAMP(F, sn_); ++sn_; })) {
        int r = it;
        if (r < I_ADA) {
            const int kc = r / 96, ng = r % 96, n = ng * 64 + lane; f32x4 acc = {0.f, 0.f, 0.f, 0.f};
            const float* wp = w_ada + (size_t)(kc * 128) * 6144 + n;
            for (int h = 0; h < 4; ++h) { float wv[32];
#pragma unroll
                for (int k = 0; k < 32; ++k) wv[k] = __builtin_nontemporal_load(wp + (size_t)(h * 32 + k) * 6144);
#pragma unroll
                for (int k = 0; k < 32; ++k) acc += sil[kc * 128 + h * 32 + k] * wv[k]; }
#pragma unroll
            for (int b = 0; b < 4; ++b) modp[(size_t)(kc * 4 + b) * 6144 + n] = acc[b];
            continue; } r -= I_ADA;
        if (r < I_EFF) {
            const int g = r >> 8, nb = (r >> 4) & 15, c0 = (r & 15) * 8, n = nb * 64 + lane; float acc[8];
#pragma unroll
            for (int cc = 0; cc < 8; ++cc) acc[cc] = 0.f;
            const float* wo_p = w_out + (size_t)(512 + g * 128) * 1024 + n;
#pragma unroll
            for (int cc = 0; cc < 8; ++cc)
#pragma unroll
                for (int hh = 0; hh < 2; ++hh) { const int e = hh * 64 + lane; scr[e * 8 + cc] = w_pool[(size_t)(g * 128 + c0 + cc) * 128 + e] * pool_scale[g * 128 + e]; }
            LDS_WAIT(); asm volatile("" ::: "memory");
            for (int h = 0; h < 8; ++h) { float wo[16];
#pragma unroll
                for (int e = 0; e < 16; ++e) wo[e] = wo_p[(size_t)(h * 16 + e) * 1024];
#pragma unroll
                for (int e = 0; e < 16; ++e) { const f32x4 wa = *(const LAS f32x4*)(scr + (h * 16 + e) * 8), wb = *(const LAS f32x4*)(scr + (h * 16 + e) * 8 + 4);
                    acc[0] += wa.x * wo[e]; acc[1] += wa.y * wo[e]; acc[2] += wa.z * wo[e]; acc[3] += wa.w * wo[e];
                    acc[4] += wb.x * wo[e]; acc[5] += wb.y * wo[e]; acc[6] += wb.z * wo[e]; acc[7] += wb.w * wo[e]; } }
            LDS_WAIT(); asm volatile("" ::: "memory");
            v4u o; o.x = pk2(acc[0], acc[1]); o.y = pk2(acc[2], acc[3]); o.z = pk2(acc[4], acc[5]); o.w = pk2(acc[6], acc[7]);
            *(GAS v4u*)(Wout_t + (size_t)n * 1024 + 512 + g * 128 + c0) = o;
            continue; } r -= I_EFF;
        if (r < I_WIN) { const int kb = r >> 5, nb = r & 31; transpose_item(w_in, PJ, kb * 64, nb * 64, Win_t, (size_t)nb * 64, 1024, kb * 64, scr, lane); continue; } r -= I_WIN;
        { const int kb = r >> 4, nb = r & 15; transpose_item(w_out, 1024, kb * 64, nb * 64, Wout_t, (size_t)nb * 64, 1024, kb * 64, scr, lane); }
    }
}
__device__ __forceinline__ void expert_item(Frame& F, const Args& A, int r, LAS float* scr) {
    const float* w_gate = A.in[14]; const float* w_up = A.in[15]; const float* w_down = A.in[16];
    bf16* Wgu_t = (bf16*)(F.ws + WS_WGU); bf16* Wd_t = (bf16*)(F.ws + WS_WD);
    if (r < 2 * I_EXP) { const int up = r >= I_EXP; if (up) r -= I_EXP; const int e = r >> 7, kb = (r >> 3) & 15, nb = r & 7, n0 = nb * 64;
        const float* W = (up ? w_up : w_gate) + (size_t)e * D * EH;
        transpose_item(W, EH, kb * 64, n0, Wgu_t, (size_t)e * 1024 + (n0 >> 7) * 256 + up * 128 + (n0 & 127), 1024, kb * 64, scr, F.lane); return; }
    r -= 2 * I_EXP;
    { const int e = r >> 7, kb = (r >> 4) & 7, nb = r & 15;
        transpose_item(w_down + (size_t)e * EH * D, D, kb * 64, nb * 64, Wd_t, (size_t)e * 1024 + nb * 64, 512, kb * 64, scr, F.lane); }
}

__device__ __forceinline__ void p1_lnmod(Frame& F, const Args& A) {
    const float* x = A.in[0]; const float* b_ada = A.in[3]; const float* modp = (const float*)(F.ws + WS_MODP); float* mod = (float*)(F.ws + WS_MOD);
    bf16* XN = (bf16*)(F.ws + WS_XN);
    LAS float* sc = (LAS float*)F.lds; LAS float* sh = sc + 1024;
    for (int vb = F.vcu; vb < 256; vb += F.G) {
        const int b = vb >> 6;
        __syncthreads();
        for (int col = F.tid; col < 1024; col += NWAVES * 64) { float a = b_ada[col], s = b_ada[1024 + col];
#pragma unroll
            for (int kc = 0; kc < 8; ++kc) { a += modp[(size_t)(kc * 4 + b) * 6144 + col]; s += modp[(size_t)(kc * 4 + b) * 6144 + 1024 + col]; }
            sh[col] = a; sc[col] = 1.f + s; }
        if (F.tid < 96) { const int n = vb * 96 + F.tid, bb = n / 6144, nn = n % 6144; float a = b_ada[nn];
#pragma unroll
            for (int kc = 0; kc < 8; ++kc) a += modp[(size_t)(kc * 4 + bb) * 6144 + nn];
            mod[n] = a; }
        __syncthreads();
        f32x4 nx[4];
        { const GAS f32x4* x0 = (const GAS f32x4*)(x + (size_t)(vb * 64 + F.wave * 8) * D) + F.lane;
#pragma unroll
          for (int j = 0; j < 4; ++j) nx[j] = x0[64 * j]; }
        for (int i = 0; i < 8; ++i) {
            const int m = vb * 64 + F.wave * 8 + i;
            f32x4 v[4]; float s = 0.f;
#pragma unroll
            for (int j = 0; j < 4; ++j) { v[j] = nx[j]; s += (v[j].x + v[j].y) + (v[j].z + v[j].w); }
            if (i < 7) { const GAS f32x4* xn = (const GAS f32x4*)(x + (size_t)(m + 1) * D) + F.lane;
#pragma unroll
                for (int j = 0; j < 4; ++j) nx[j] = xn[64 * j]; }
            const float mean = wave_sum(s) * (1.f / D); float s2 = 0.f;
#pragma unroll
            for (int j = 0; j < 4; ++j) { v[j] = v[j] - mean; s2 += (v[j].x * v[j].x + v[j].y * v[j].y) + (v[j].z * v[j].z + v[j].w * v[j].w); }
            const float rstd = 1.f / sqrtf(wave_sum(s2) * (1.f / D) + LN_EPS);
            GAS v2u* o8 = (GAS v2u*)(XN + (size_t)m * D) + F.lane;
#pragma unroll
            for (int j = 0; j < 4; ++j) { const f32x4 a = *(const LAS f32x4*)(sc + 256 * j + 4 * F.lane), bsh = *(const LAS f32x4*)(sh + 256 * j + 4 * F.lane);
                const f32x4 o = v[j] * rstd * a + bsh; v2u w; w.x = pk2(o.x, o.y); w.y = pk2(o.z, o.w); o8[64 * j] = w; }
        }
    }
}

__device__ __forceinline__ int crow(int r, int hi) { return (r & 3) + 8 * (r >> 2) + 4 * hi; }
__device__ __forceinline__ s16x4 vtr(const LAS unsigned char* p) { return __builtin_bit_cast(s16x4, __builtin_amdgcn_ds_read_tr16_b64_v4i16((LAS s16x4*)p)); }
#ifndef ATT_EARLY_EXIT
#define ATT_EARLY_EXIT 1
#endif
template <bool DIAG> __device__ __forceinline__ void sb_group(float& z0, float& z1, float& z2, float& z3, float& R, int hi, int key0, int qabs) {
    float be[4], w[4]; const float z[4] = {z0, z1, z2, z3};
#pragma unroll
    for (int i = 0; i < 4; ++i) { const float t = __builtin_amdgcn_exp2f(-__builtin_fmaxf(z[i], -126.f));
        be[i] = __builtin_amdgcn_rcpf(1.f + t); w[i] = t * be[i];
        if (DIAG) { if (key0 + i >= qabs) { be[i] = 0.f; w[i] = 1.f; } } }
    const float G = ((w[3] * w[2]) * w[1]) * w[0];
    auto sw = __builtin_amdgcn_permlane32_swap(__float_as_uint(G), __float_as_uint(G), false, false);
    const float Glo = __uint_as_float(sw[0]), Ghi = __uint_as_float(sw[1]);
    const float off = hi ? R : R * Ghi;
    const float o2 = off * w[3], o1 = o2 * w[2], o0 = o1 * w[1];
    z3 = be[3] * off; z2 = be[2] * o2; z1 = be[1] * o1; z0 = be[0] * o0;
    R = R * (Glo * Ghi);
}
template <bool DIAG> __device__ __forceinline__ void sb_tile(f32x16& p0, f32x16& p1, float& R, int hi, int kb, int qabs) {
#pragma unroll
    for (int g = 3; g >= 0; --g) { float a = p1[4 * g], b = p1[4 * g + 1], c = p1[4 * g + 2], d = p1[4 * g + 3];
        sb_group<DIAG>(a, b, c, d, R, hi, kb + 32 + 8 * g + 4 * hi, qabs); p1[4 * g] = a; p1[4 * g + 1] = b; p1[4 * g + 2] = c; p1[4 * g + 3] = d; }
#pragma unroll
    for (int g = 3; g >= 0; --g) { float a = p0[4 * g], b = p0[4 * g + 1], c = p0[4 * g + 2], d = p0[4 * g + 3];
        sb_group<DIAG>(a, b, c, d, R, hi, kb + 8 * g + 4 * hi, qabs); p0[4 * g] = a; p0[4 * g + 1] = b; p0[4 * g + 2] = c; p0[4 * g + 3] = d; }
}
__device__ __forceinline__ void attn_unit(int b, int h, int qb, const bf16* Q, const bf16* K, const bf16* V, bf16* AO, LAS unsigned char* wl  , int lane) {
    const int r32 = lane & 31, hi = lane >> 5, q0 = qb * 32, qabs = q0 + r32; const size_t rowbase = (size_t)b * S;
    const int jmax = q0 >> 6;
    const int srow = lane >> 3, sch = lane & 7;
    const unsigned voff = (unsigned)(srow * SBW + sch * 8);
    const bf16* Kt = K + (rowbase + (size_t)jmax * 64) * SBW + h * 64;
    const bf16* Vt = V + (rowbase + (size_t)jmax * 64) * SBW + h * 64;
    v4u kk[8], vv[8];
#pragma unroll
    for (int i = 0; i < 8; ++i) { kk[i] = *(const v4u*)(Kt + i * 8 * SBW + voff); vv[i] = *(const v4u*)(Vt + i * 8 * SBW + voff); }
    const bf16* Qw = Q + (rowbase + q0 + r32) * SBW + h * 64 + hi * 8;
    bf16x8 qr[4];
#pragma unroll
    for (int d0 = 0; d0 < 4; ++d0) qr[d0] = *(const bf16x8*)(Qw + d0 * 16);
    f32x16 o0, o1;
#pragma unroll
    for (int r = 0; r < 16; ++r) { o0[r] = 0.f; o1[r] = 0.f; }
    float R = 1.f;
    LAS unsigned char* kl = wl; LAS unsigned char* vl = wl + 8192;
    const LAS unsigned char* vp = vl + ((lane >> 4) & 1) * 32 + (lane & 3) * 8 + (4 * hi + ((lane & 15) >> 2)) * 64;
    LAS unsigned char* kwb = kl + sch * 1024 + ((srow ^ sch) * 16); LAS unsigned char* vwb = vl + (sch >> 2) * 4096 + srow * 64 + (sch & 3) * 16;
    for (int j = jmax; j >= 0; --j) {
#pragma unroll
        for (int i = 0; i < 8; ++i) {
            *(LAS v4u*)(kwb + i * 128) = kk[i];
            *(LAS v4u*)(vwb + (i >> 1) * 1024 + (i & 1) * 512) = vv[i]; }
        if (j > 0) {
            Kt -= (size_t)64 * SBW; Vt -= (size_t)64 * SBW;
#pragma unroll
            for (int i = 0; i < 8; ++i) { kk[i] = *(const v4u*)(Kt + i * 8 * SBW + voff); vv[i] = *(const v4u*)(Vt + i * 8 * SBW + voff); }
        }
        f32x16 p0, p1;
#pragma unroll
        for (int r = 0; r < 16; ++r) { p0[r] = 0.f; p1[r] = 0.f; }
#pragma unroll
        for (int d0 = 0; d0 < 4; ++d0) { const int c = 2 * d0 + hi;
            const bf16x8 k0 = *(const LAS bf16x8*)(kl + c * 1024 + ((r32 ^ c) * 16)), k1 = *(const LAS bf16x8*)(kl + c * 1024 + 512 + ((r32 ^ c) * 16));
            p0 = __builtin_amdgcn_mfma_f32_32x32x16_bf16(k0, qr[d0], p0, 0, 0, 0); p1 = __builtin_amdgcn_mfma_f32_32x32x16_bf16(k1, qr[d0], p1, 0, 0, 0); }
        if (j == jmax) sb_tile<true>(p0, p1, R, hi, 64 * j, qabs); else sb_tile<false>(p0, p1, R, hi, 64 * j, qabs);
        bf16x8 pa[4];
        { v4u w;
          w.x = pk2(p0[0], p0[1]); w.y = pk2(p0[2], p0[3]); w.z = pk2(p0[4], p0[5]); w.w = pk2(p0[6], p0[7]); pa[0] = __builtin_bit_cast(bf16x8, w);
          w.x = pk2(p0[8], p0[9]); w.y = pk2(p0[10], p0[11]); w.z = pk2(p0[12], p0[13]); w.w = pk2(p0[14], p0[15]); pa[1] = __builtin_bit_cast(bf16x8, w);
          w.x = pk2(p1[0], p1[1]); w.y = pk2(p1[2], p1[3]); w.z = pk2(p1[4], p1[5]); w.w = pk2(p1[6], p1[7]); pa[2] = __builtin_bit_cast(bf16x8, w);
          w.x = pk2(p1[8], p1[9]); w.y = pk2(p1[10], p1[11]); w.z = pk2(p1[12], p1[13]); w.w = pk2(p1[14], p1[15]); pa[3] = __builtin_bit_cast(bf16x8, w); }
#pragma unroll
        for (int ks = 0; ks < 4; ++ks) {
            const s16x4 l0 = vtr(vp + ks * 1024), h0 = vtr(vp + ks * 1024 + 512), l1 = vtr(vp + 4096 + ks * 1024), h1 = vtr(vp + 4096 + ks * 1024 + 512);
            const bf16x8 f0 = {l0[0], l0[1], l0[2], l0[3], h0[0], h0[1], h0[2], h0[3]}, f1 = {l1[0], l1[1], l1[2], l1[3], h1[0], h1[1], h1[2], h1[3]};
            o0 = __builtin_amdgcn_mfma_f32_32x32x16_bf16(pa[ks], f0, o0, 0, 0, 0);
            o1 = __builtin_amdgcn_mfma_f32_32x32x16_bf16(pa[ks], f1, o1, 0, 0, 0);
        }
#if ATT_EARLY_EXIT
        if (__all(R < 1.17549435e-38f)) break;
#endif
    }
    { LAS bf16* stg = (LAS bf16*)kl;
#pragma unroll
      for (int r = 0; r < 16; ++r) { const int q = crow(r, hi); stg[q * 64 + r32] = (bf16)f2bf(o0[r]); stg[q * 64 + 32 + r32] = (bf16)f2bf(o1[r]); }
      bf16* Ow = AO + (rowbase + q0) * D + h * 64;
#pragma unroll
      for (int i = 0; i < 4; ++i) { const int row = i * 8 + (lane >> 3), ch = lane & 7; const v4u v = *(const LAS v4u*)(stg + row * 64 + ch * 8); *(GAS v4u*)(Ow + (size_t)row * D + ch * 8) = v; } }
}
__device__ __forceinline__ void pool_item(int it, const bf16* P, bf16* AO, int lane) {
    const int m0 = it * 8, t0 = m0 & (S - 1), w = 2 << (lane >> 4);
    const bf16* Pc = P + lane * 8;
    v4u hal[15], cur[8];
#pragma unroll
    for (int k = 1; k <= 15; ++k) { hal[k - 1] = (v4u){0u, 0u, 0u, 0u}; if (k < w && t0 - k >= 0) hal[k - 1] = *(const v4u*)(Pc + (size_t)(m0 - k) * SBW); }
#pragma unroll
    for (int r = 0; r < 8; ++r) cur[r] = *(const v4u*)(Pc + (size_t)(m0 + r) * SBW);
#pragma unroll
    for (int r = 0; r < 8; ++r) {
        float s[8];
#pragma unroll
        for (int i = 0; i < 8; ++i) s[i] = 0.f;
#pragma unroll
        for (int k = 0; k <= 15; ++k) {
            const int rr = r - k;
            const v4u v = rr >= 0 ? cur[rr >= 0 ? rr : 0] : hal[rr >= 0 ? 0 : -rr - 1];
            if (k < w) { s[0] += bf_lo(v.x); s[1] += bf_hi(v.x); s[2] += bf_lo(v.y); s[3] += bf_hi(v.y); s[4] += bf_lo(v.z); s[5] += bf_hi(v.z); s[6] += bf_lo(v.w); s[7] += bf_hi(v.w); }
        }
        const int t = t0 + r; const float inv = 1.f / (float)((t + 1 < w) ? t + 1 : w);
        const v4u c = cur[r];
        v4u o; o.x = pk2(s[0] * inv - bf_lo(c.x), s[1] * inv - bf_hi(c.x)); o.y = pk2(s[2] * inv - bf_lo(c.y), s[3] * inv - bf_hi(c.y));
        o.z = pk2(s[4] * inv - bf_lo(c.z), s[5] * inv - bf_hi(c.z)); o.w = pk2(s[6] * inv - bf_lo(c.w), s[7] * inv - bf_hi(c.w));
        *(GAS v4u*)(AO + (size_t)(m0 + r) * D + 512 + lane * 8) = o;
    }
}
__device__ __forceinline__ void p3_attn_pool(Frame& F, const Args& A) {
    const bf16* Q = (const bf16*)(F.ws + WS_Q); const bf16* K = Q + (size_t)M * SBW; const bf16* V = K + (size_t)M * SBW; const bf16* P = V + (size_t)M * SBW;
    bf16* AO = (bf16*)(F.ws + WS_AO);
    const int gw = F.vcu * NWAVES + F.wave, NGW = F.G * NWAVES;
    LAS unsigned char* wl = F.lds + F.wave * WSCR;
    SUBSTAMP(F, 70);
    if (F.wave & 1) { for (int it = gw; it < 3 * I_EXP; it += NGW) expert_item(F, A, it, (LAS float*)wl);
        for (int it = gw; it < M / 8; it += NGW) pool_item(it, P, AO, F.lane); }
    SUBSTAMP(F, 71);
    for (int uid = gw; uid < NB * NH * (S / 32); uid += NGW) attn_unit(uid >> 10, (uid >> 7) & 7, uid & 127, Q, K, V, AO, wl, F.lane);
    SUBSTAMP(F, 72);
    if (!(F.wave & 1)) { for (int it = gw; it < M / 8; it += NGW) pool_item(it, P, AO, F.lane);
        for (int it = gw; it < 3 * I_EXP; it += NGW) expert_item(F, A, it, (LAS float*)wl); }
    SUBSTAMP(F, 73);
}

__device__ __forceinline__ void moe_tiles(Frame& F, int& tstart, int& tend, int& total, int& cnt) {
    const int n = F.lane < 16 ? (int)__hip_atomic_load(F.ctl + CW_CNT + 64 * F.lane, RLX_AGENT) : 0;
    const int tiles = (n + 255) >> 8; int incl = tiles;
#pragma unroll
    for (int o = 1; o < 16; o <<= 1) { const int v = __shfl_up(incl, o); if (F.lane >= o) incl += v; }
    tend = F.lane < 16 ? incl : 0x7fffffff; tstart = incl - tiles; total = __builtin_amdgcn_readlane(incl, 15); cnt = n;
}

__device__ __forceinline__ void route_row(const float (&pl)[20], int& ea, int& eb, float& w1, float& w2) {
    float gl[4], el[16];
#pragma unroll
    for (int t = 0; t < 4; ++t) gl[t] = pl[t];
#pragma unroll
    for (int t = 0; t < 16; ++t) el[t] = pl[4 + t];
    int gi = 0; float gm = gl[0];
#pragma unroll
    for (int t = 1; t < 4; ++t) if (gl[t] > gm) { gm = gl[t]; gi = t; }
    float den = 0.f;
#pragma unroll
    for (int t = 0; t < 4; ++t) den += __expf(gl[t] - gm);
    const float gp = 1.f / den;
    float es[4];
#pragma unroll
    for (int t = 0; t < 4; ++t) es[t] = gi == 0 ? el[t] : gi == 1 ? el[4 + t] : gi == 2 ? el[8 + t] : el[12 + t];
    int i1 = 0; float v1 = es[0];
#pragma unroll
    for (int t = 1; t < 4; ++t) if (es[t] > v1) { v1 = es[t]; i1 = t; }
    int i2 = 0; float v2 = -INFINITY;
#pragma unroll
    for (int t = 0; t < 4; ++t) if (t != i1 && es[t] > v2) { v2 = es[t]; i2 = t; }
    const float e2 = __expf(v2 - v1); w1 = gp / (1.f + e2); w2 = gp * e2 / (1.f + e2);
    ea = gi * 4 + i1; eb = gi * 4 + i2;
}
__device__ __forceinline__ void p5_post(Frame& F, const Args& A, const bool dry = false) {
    const float* x = A.in[0]; const float* ln1_g = A.in[8]; const float* ln1_b = A.in[9]; const float* w_rg = A.in[10]; const float* b_rg = A.in[11]; const float* w_re = A.in[12]; const float* b_re = A.in[13];
    const float* mod = (const float*)(F.ws + WS_MOD); const bf16* MIX = (const bf16*)(F.ws + WS_MIX);
    bf16* U2 = (bf16*)(F.ws + (dry ? WS_AO : WS_XN)); unsigned* route = (unsigned*)(F.ws + WS_ROUTE); int* eidx = (int*)(F.ws + WS_IDX);
    float* x1o = dry ? (float*)(F.ws + WS_HS) : F.out;
    LAS f32x4* Wl = (LAS f32x4*)F.lds;
    LAS f32x4* Lg1 = (LAS f32x4*)(F.lds + 81920); LAS f32x4* Lb1 = Lg1 + 256; LAS f32x4* Ls2 = Lb1 + 256; LAS f32x4* Lh2 = Ls2 + 256;
    LAS int* asg = (LAS int*)(F.lds + 98304);
    LAS int* rnk = asg + 128; LAS int* lcnt = rnk + 128; LAS int* lbase = lcnt + 16; LAS float* wts = (LAS float*)(lbase + 16);
    SUBSTAMP(F, 50);
    LAS float* lgs = (LAS float*)(F.lds + 100352);
    for (int idx = F.tid; idx < 5 * 1024; idx += NWAVES * 64) { const int j5 = idx >> 10, col = idx & 1023;
        const f32x4 v = (j5 == 0) ? *(const f32x4*)(w_rg + col * 4) : *(const f32x4*)(w_re + col * 16 + (j5 - 1) * 4);
        Wl[j5 * 1024 + ((col >> 8) * 4 + (col & 3)) * 64 + ((col >> 2) & 63)] = v; }
    if (F.tid < 256) { Lg1[F.tid] = ((const f32x4*)ln1_g)[F.tid]; Lb1[F.tid] = ((const f32x4*)ln1_b)[F.tid]; }
    LAS float* Lbias = (LAS float*)(F.lds + 99840);
    if (F.tid < 20) Lbias[F.tid] = F.tid < 4 ? b_rg[F.tid] : b_re[F.tid - 4];
    for (int vb = F.vcu; vb < 256; vb += F.G) {
        const int b = vb >> 6;
        __syncthreads();
        if (F.tid < 256) { Ls2[F.tid] = ((const f32x4*)(mod + b * 6144 + 4096))[F.tid] + 1.0f; Lh2[F.tid] = ((const f32x4*)(mod + b * 6144 + 3072))[F.tid]; }
        if (F.tid < 16) lcnt[F.tid] = 0;
        __syncthreads();
        const int m0 = vb * 64 + F.wave * 8;
        SUBSTAMP(F, 51);
        f32x4 nx[4]; v2u nm[4];
#pragma unroll
        for (int j = 0; j < 4; ++j) { nx[j] = ((const GAS f32x4*)(x + (size_t)m0 * D))[64 * j + F.lane]; nm[j] = ((const GAS v2u*)(MIX + (size_t)m0 * D))[64 * j + F.lane]; }
        for (int i = 0; i < 8; ++i) {
            const int m = m0 + i;
            f32x4 v[4]; float s = 0.f;
#pragma unroll
            for (int j = 0; j < 4; ++j) { const v2u mm = nm[j]; const f32x4 mx = {bf_lo(mm.x), bf_hi(mm.x), bf_lo(mm.y), bf_hi(mm.y)};
                v[j] = nx[j] * ALPHA + mx; s += (v[j].x + v[j].y) + (v[j].z + v[j].w); }
            if (i < 7) {
#pragma unroll
                for (int j = 0; j < 4; ++j) { nx[j] = ((const GAS f32x4*)(x + (size_t)(m + 1) * D))[64 * j + F.lane]; nm[j] = ((const GAS v2u*)(MIX + (size_t)(m + 1) * D))[64 * j + F.lane]; } }
            float mean = wave_sum(s) * (1.f / D), q = 0.f;
#pragma unroll
            for (int j = 0; j < 4; ++j) { v[j] = v[j] - mean; q += (v[j].x * v[j].x + v[j].y * v[j].y) + (v[j].z * v[j].z + v[j].w * v[j].w); }
            float rstd = 1.f / sqrtf(wave_sum(q) * (1.f / D) + LN_EPS);
            s = 0.f;
            GAS f32x4* xw = (GAS f32x4*)(x1o + (size_t)m * D) + F.lane;
#pragma unroll
            for (int j = 0; j < 4; ++j) { v[j] = v[j] * rstd * Lg1[64 * j + F.lane] + Lb1[64 * j + F.lane]; xw[64 * j] = v[j]; s += (v[j].x + v[j].y) + (v[j].z + v[j].w); }
            mean = wave_sum(s) * (1.f / D); q = 0.f;
#pragma unroll
            for (int j = 0; j < 4; ++j) { v[j] = v[j] - mean; q += (v[j].x * v[j].x + v[j].y * v[j].y) + (v[j].z * v[j].z + v[j].w * v[j].w); }
            rstd = 1.f / sqrtf(wave_sum(q) * (1.f / D) + LN_EPS);
            float pl[20];
#pragma unroll
            for (int t = 0; t < 20; ++t) pl[t] = 0.f;
#pragma unroll
            for (int j = 0; j < 4; ++j) { v[j] = v[j] * rstd * Ls2[64 * j + F.lane] + Lh2[64 * j + F.lane]; v2u w; w.x = pk2(v[j].x, v[j].y); w.y = pk2(v[j].z, v[j].w);
                ((GAS v2u*)(U2 + (size_t)m * D))[64 * j + F.lane] = w;
                f32x4 wv[4][5];
#pragma unroll
                for (int i4 = 0; i4 < 4; ++i4)
#pragma unroll
                    for (int j5 = 0; j5 < 5; ++j5) wv[i4][j5] = Wl[j5 * 1024 + (j * 4 + i4) * 64 + F.lane];
#pragma unroll
                for (int i4 = 0; i4 < 4; ++i4) { const float uu = v[j][i4];
#pragma unroll
                    for (int j5 = 0; j5 < 5; ++j5) { pl[j5 * 4 + 0] += uu * wv[i4][j5].x; pl[j5 * 4 + 1] += uu * wv[i4][j5].y; pl[j5 * 4 + 2] += uu * wv[i4][j5].z; pl[j5 * 4 + 3] += uu * wv[i4][j5].w; } } }
            {
                LAS float* lg = lgs + (F.wave * 8 + i) * 20;
#pragma unroll
                for (int t = 0; t < 20; ++t) pl[t] = wave_sum(pl[t]);
                if (F.lane == 0) {
#pragma unroll
                    for (int t = 0; t < 20; ++t) lg[t] = pl[t]; }
            }
        }
        SUBSTAMP(F, 52);
        __syncthreads();
        if (F.tid < 64) {
            float pl[20];
#pragma unroll
            for (int t = 0; t < 20; ++t) pl[t] = lgs[F.tid * 20 + t] + Lbias[t];
            int ea, eb; float w1, w2; route_row(pl, ea, eb, w1, w2);
            asg[2 * F.tid] = ea; asg[2 * F.tid + 1] = eb; wts[2 * F.tid] = w1; wts[2 * F.tid + 1] = w2;
        }
        __syncthreads();
        if (F.tid < 128) rnk[F.tid] = atomicAdd((int*)&lcnt[asg[F.tid]], 1);
        __syncthreads();
        if (F.tid < 16) lbase[F.tid] = dry ? 0 : (int)__hip_atomic_fetch_add(F.ctl + CW_CNT + 64 * F.tid, (unsigned)lcnt[F.tid], RLX_AGENT);
        __syncthreads();
        if (F.tid < 128 && !dry) { const int m = vb * 64 + (F.tid >> 1), k = F.tid & 1, e = asg[F.tid];
            route[(size_t)m * 8 + 2 * k] = (unsigned)e; route[(size_t)m * 8 + 2 * k + 1] = (unsigned)(lbase[e] + rnk[F.tid]); eidx[e * 16384 + lbase[e] + rnk[F.tid]] = m; route[(size_t)m * 8 + 4 + k] = __float_as_uint(wts[F.tid]); }
    }
    SUBSTAMP(F, 53);
}

__device__ __forceinline__ void p6_gather(Frame& F) {
    const bf16* U2 = (const bf16*)(F.ws + WS_XN); bf16* XS = (bf16*)(F.ws + WS_XS); const unsigned* route = (const unsigned*)(F.ws + WS_ROUTE);
    int tstart, tend, total, ecnt; moe_tiles(F, tstart, tend, total, ecnt);
    const int gw = F.vcu * NWAVES + F.wave, NGW = F.G * NWAVES;
    for (int m = gw; m < M; m += NGW) {
        const v4u rt = *(const v4u*)(route + (size_t)m * 8);
        const int r1 = __shfl(tstart, (int)rt.x) * 256 + (int)rt.y, r2 = __shfl(tstart, (int)rt.z) * 256 + (int)rt.w;
        const GAS v4u* src = (const GAS v4u*)(U2 + (size_t)m * D) + F.lane;
        const v4u a = src[0], c = src[64];
        GAS v4u* d1 = (GAS v4u*)(XS + (size_t)r1 * D) + F.lane; GAS v4u* d2 = (GAS v4u*)(XS + (size_t)r2 * D) + F.lane;
        d1[0] = a; d1[64] = c; d2[0] = a; d2[64] = c;
    }
}

__device__ __forceinline__ void p9_final(Frame& F, const Args& A, const bool dry = false) {
    const float* ln2_g = A.in[17]; const float* ln2_b = A.in[18]; const float* mod = (const float*)(F.ws + WS_MOD);
    const bf16* YS = (const bf16*)(F.ws + WS_XS); const unsigned* route = (const unsigned*)(F.ws + WS_ROUTE);
    int tstart, tend, total, ecnt; moe_tiles(F, tstart, tend, total, ecnt);
    const int gw = F.vcu * NWAVES + F.wave, NGW = F.G * NWAVES;
    f32x4 g2[4], b2[4];
#pragma unroll
    for (int j = 0; j < 4; ++j) { g2[j] = ((const f32x4*)ln2_g)[64 * j + F.lane]; b2[j] = ((const f32x4*)ln2_b)[64 * j + F.lane]; }
    for (int mb = gw * 8; mb < M; mb += NGW * 8) {
        f32x4 xv[4]; v2u ya[4], yc[4]; v2u wt;
        { const v4u rt = *(const v4u*)(route + (size_t)mb * 8); wt = *(const v2u*)(route + (size_t)mb * 8 + 4);
          const int r1 = __shfl(tstart, (int)rt.x) * 256 + (int)rt.y, r2 = __shfl(tstart, (int)rt.z) * 256 + (int)rt.w;
#pragma unroll
          for (int j = 0; j < 4; ++j) { xv[j] = ((const GAS f32x4*)(F.out + (size_t)mb * D))[64 * j + F.lane]; ya[j] = ((const GAS v2u*)(YS + (size_t)r1 * D))[64 * j + F.lane]; yc[j] = ((const GAS v2u*)(YS + (size_t)r2 * D))[64 * j + F.lane]; } }
        for (int i = 0; i < 8; ++i) {
            const int m = mb + i, b = m >> 12;
            const float w1 = __uint_as_float(wt.x), w2 = __uint_as_float(wt.y);
            f32x4 v[4]; float s = 0.f;
#pragma unroll
            for (int j = 0; j < 4; ++j) { const v2u a = ya[j], c = yc[j];
                const f32x4 gt = ((const f32x4*)(mod + b * 6144 + 5120))[64 * j + F.lane] + 1.0f;
                f32x4 y; y.x = w1 * bf_lo(a.x) + w2 * bf_lo(c.x); y.y = w1 * bf_hi(a.x) + w2 * bf_hi(c.x); y.z = w1 * bf_lo(a.y) + w2 * bf_lo(c.y); y.w = w1 * bf_hi(a.y) + w2 * bf_hi(c.y);
                v[j] = xv[j] * ALPHA + gt * y; s += (v[j].x + v[j].y) + (v[j].z + v[j].w); }
            if (i < 7) { const v4u rt = *(const v4u*)(route + (size_t)(m + 1) * 8); wt = *(const v2u*)(route + (size_t)(m + 1) * 8 + 4);
                const int r1 = __shfl(tstart, (int)rt.x) * 256 + (int)rt.y, r2 = __shfl(tstart, (int)rt.z) * 256 + (int)rt.w;
#pragma unroll
                for (int j = 0; j < 4; ++j) { xv[j] = ((const GAS f32x4*)(F.out + (size_t)(m + 1) * D))[64 * j + F.lane]; ya[j] = ((const GAS v2u*)(YS + (size_t)r1 * D))[64 * j + F.lane]; yc[j] = ((const GAS v2u*)(YS + (size_t)r2 * D))[64 * j + F.lane]; } }
            const float mean = wave_sum(s) * (1.f / D); float q = 0.f;
#pragma unroll
            for (int j = 0; j < 4; ++j) { v[j] = v[j] - mean; q += (v[j].x * v[j].x + v[j].y * v[j].y) + (v[j].z * v[j].z + v[j].w * v[j].w); }
            const float rstd = 1.f / sqrtf(wave_sum(q) * (1.f / D) + LN_EPS);
            GAS f32x4* ow = (GAS f32x4*)((dry ? (float*)(F.ws + WS_HS) : F.out) + (size_t)m * D) + F.lane;
#pragma unroll
            for (int j = 0; j < 4; ++j) ow[64 * j] = v[j] * rstd * g2[j] + b2[j];
        }
    }
}

__global__ void __launch_bounds__(NWAVES * 64, 2) mk_fwd(Args args) {
    extern __shared__ __attribute__((aligned(16))) unsigned char lds[];
    Frame F;
    F.lds = (LAS unsigned char*)lds;
    F.MISC = (volatile LAS unsigned*)(F.lds + MISC_OFF);
    F.tid = threadIdx.x; F.lane = F.tid & 63; F.wave = __builtin_amdgcn_readfirstlane(F.tid >> 6);
    F.G = gridDim.x; { const int bx = blockIdx.x; F.vcu = (F.G % 8 == 0) ? (bx % 8) * (F.G / 8) + bx / 8 : bx; }
    F.ws = args.ws; F.out = args.out; F.ctl = (gu32*)(args.ws + WS_CTL);
    for (int u = F.tid; u < (LDS_BYTES - LDSCTL_OFF) / 4; u += NWAVES * 64) ((LAS unsigned*)(F.lds + LDSCTL_OFF))[u] = 0u;
    __syncthreads();
    XcdBarrier bar; bar.bar = (unsigned*)(F.ctl + CW_BAR); bar.x = 0; bar.st = nullptr;
    if (N_LAUNCHES == 1) bar = xcd_barrier_post((unsigned*)(F.ctl + CW_BAR), F.MISC + 8);
#define GRID_BAR() do { if (N_LAUNCHES == 1) xcd_barrier(bar); } while (0)
#ifndef PROBE_STAMP
#define PROBE_STAMP -1
#endif
    F.ta = 0; F.tb = 0;
#define STAMP(k) do { if (PROBE_STAMP >= 0 && blockIdx.x == STAMP_BX && F.tid == 0) { const unsigned long long t_ = __builtin_amdgcn_s_memrealtime(); if ((k) == PROBE_STAMP) F.ta = t_; if ((k) == PROBE_STAMP + 1) F.tb = t_; } } while (0)
    STAMP(0);
    const int lo = args.ph_lo, hi = args.ph_hi;
#ifndef PROBE_DOUBLE
#define PROBE_DOUBLE -1
#endif
#define REP(k) for (int rep_ = 0; rep_ < ((PROBE_DOUBLE == (k)) ? 2 : 1); ++rep_)
#define IN(k) (lo <= (k) && (k) < hi)
#define BOTH(k) (IN(k) && IN((k) + 1))
    bf16* XN = (bf16*)(F.ws + WS_XN);
    if (IN(0)) REP(0) { p0_prologue(F, args); if (BOTH(0)) GRID_BAR(); }
    STAMP(1);
    if (IN(1)) REP(1) { p1_lnmod(F, args); if (BOTH(1)) GRID_BAR(); }
    STAMP(2);
    if (IN(2)) REP(2) {
        __syncthreads();
        pg8::Gemm g{XN, (const bf16*)(F.ws + WS_WIN), M, PJ, D}; pg8::StaticOrder So; So.init(M, PJ, F.G, (int)blockIdx.x);
        pg8::EpiQKVP E{(bf16*)(F.ws + WS_Q), (size_t)M * SBW, QSCALE};
        pg8::gemm_phase<pg8::EpiQKVP, pg8::StaticOrder, PG8_ALIGN, PG8_SP2>(F.lds + RING_OFF, g, So, E);
        if (BOTH(2)) GRID_BAR();
    }
    STAMP(3);
    if (IN(3)) REP(3) { __syncthreads(); p3_attn_pool(F, args); if (BOTH(3)) GRID_BAR(); }
    STAMP(4);
    if (IN(4)) REP(4) {
        __syncthreads();
        pg8::Gemm g{(const bf16*)(F.ws + WS_AO), (const bf16*)(F.ws + WS_WOUT), M, D, D}; pg8::StaticOrder So; So.init(M, D, F.G, (int)blockIdx.x);
        pg8::EpiMix E{(bf16*)(F.ws + WS_MIX), (const float*)(F.ws + WS_MOD) + 2048};
        pg8::gemm_phase<pg8::EpiMix, pg8::StaticOrder, PG8_ALIGN, PG8_SP2>(F.lds + RING_OFF, g, So, E);
        if (BOTH(4)) GRID_BAR();
    }
    STAMP(5);
    if (IN(5)) { if (PROBE_DOUBLE == 5) { __syncthreads(); p5_post(F, args, true); GRID_BAR(); } __syncthreads(); p5_post(F, args); if (BOTH(5)) GRID_BAR(); }
    STAMP(6);
    STAMP(7);
    if (IN(7)) REP(7) {
        __syncthreads();
        int tstart, tend, total, ecnt; moe_tiles(F, tstart, tend, total, ecnt);
        pg8::Gemm g{(const bf16*)(F.ws + WS_XN), (const bf16*)(F.ws + WS_WGU), M, NE * 1024, D};
        pg8::MoeOrder So{tstart, tend, ecnt, total, F.G, F.vcu, F.lane, (const int*)(F.ws + WS_IDX)};
        pg8::EpiGateUp E{(bf16*)(F.ws + WS_HS)};
        pg8::gemm_phase_g<pg8::EpiGateUp, pg8::MoeOrder, PG8_ALIGN, true>(F.lds + RING_OFF, g, So, E);
        if (BOTH(7)) GRID_BAR();
    }
    STAMP(8);
    if (IN(8)) REP(8) {
        __syncthreads();
        int tstart, tend, total, ecnt; moe_tiles(F, tstart, tend, total, ecnt);
        pg8::Gemm g{(const bf16*)(F.ws + WS_HS), (const bf16*)(F.ws + WS_WD), SORT_ROWS, NE * 1024, EH};
        pg8::MoeOrder So{tstart, tend, ecnt, total, F.G, F.vcu, F.lane, (const int*)(F.ws + WS_IDX)};
        pg8::EpiDown E{(bf16*)(F.ws + WS_XS)};
        pg8::gemm_phase<pg8::EpiDown, pg8::MoeOrder, PG8_ALIGN, PG8_SP2>(F.lds + RING_OFF, g, So, E);
        if (BOTH(8)) GRID_BAR();
    }
    STAMP(9);
    if (IN(9)) { if (PROBE_DOUBLE == 9) { p9_final(F, args, true); GRID_BAR(); } p9_final(F, args); }
    STAMP(10);
    if (PROBE_STAMP >= 0 && blockIdx.x == STAMP_BX && F.tid == 0) { VM_WAIT(); F.out[(size_t)(F.vcu * NWAVES * 8) * D] += (float)(F.tb - F.ta) * 0.001f; }
#undef IN
#undef BOTH
}

extern "C" void kernel_launch(void* const* d_in, const int* in_sizes, int n_in, void* d_out, int out_size, void* d_ws, size_t ws_size, hipStream_t stream) {
    static int grid = 0;
    if (grid == 0) {
        if (n_in != 19 || in_sizes[0] != M * D || out_size != M * D || ws_size < WS_END) { fprintf(stderr, "kernel_launch: unexpected problem (n_in %d, out %d, ws %zu); nothing launched\n", n_in, out_size, ws_size); grid = -1; return; }
        int dev = 0, cus = 0, per_cu = 0;
        if (hipGetDevice(&dev) != hipSuccess || hipDeviceGetAttribute(&cus, hipDeviceAttributeMultiprocessorCount, dev) != hipSuccess) { fprintf(stderr, "kernel_launch: device query failed\n"); grid = -1; return; }
        if (hipFuncSetAttribute((const void*)mk_fwd, hipFuncAttributeMaxDynamicSharedMemorySize, LDS_BYTES) != hipSuccess) { fprintf(stderr, "kernel_launch: hipFuncSetAttribute failed\n"); grid = -1; return; }
        if (hipOccupancyMaxActiveBlocksPerMultiprocessor(&per_cu, (const void*)mk_fwd, NWAVES * 64, LDS_BYTES) != hipSuccess || per_cu < 1) { fprintf(stderr, "kernel_launch: occupancy query says %d workgroups per CU; nothing launched\n", per_cu); (void)hipGetLastError(); grid = -1; return; }
        grid = cus;
    }
    if (grid < 0) return;
    if (hipMemsetAsync((char*)d_ws + WS_CTL, 0, CTL_ZERO_BYTES, stream) != hipSuccess) { fprintf(stderr, "kernel_launch: memset failed\n"); return; }
    Args a{};
    for (int i = 0; i < 19; ++i) a.in[i] = (const float*)d_in[i];
    a.out = (float*)d_out; a.ws = (unsigned char*)d_ws;
    for (int li = 0; li < N_LAUNCHES; ++li) {
        a.ph_lo = (N_LAUNCHES == 1) ? 0 : li; a.ph_hi = (N_LAUNCHES == 1) ? N_PHASES : li + 1; a.li = li;
        hipLaunchKernelGGL(mk_fwd, dim3(grid), dim3(NWAVES * 64), LDS_BYTES, stream, a);
        const hipError_t le = hipPeekAtLastError();
        if (le != hipSuccess) { fprintf(stderr, "kernel_launch: launch %d failed: %s\n", li, hipGetErrorName(le)); break; }
    }
}
```
